# Optimizing an MI355X kernel written in HIP

```python
import jax, jax.numpy as jnp
from jax import lax
import numpy as np

D_MODEL = 1024
BATCH = 8
SEQ = 2048
DEPTH = 4
DEC_BATCH = 128
DEC_SEQ = 1
PAST_LEN = 16384
PAGE_SIZE = 128

D_MIX = D_MODEL
D_RET = D_MIX // 2
H_RET = 4
DK = D_RET // H_RET
DV = D_RET // H_RET
D_POOL = D_MIX - D_RET
POOL_WINDOWS = (2, 4, 8, 16)
N_POOL_GROUPS = len(POOL_WINDOWS)
POOL_GC = D_POOL // N_POOL_GROUPS
POOL_BUF = max(POOL_WINDOWS) - 1
D_IN = 4 * D_RET + D_POOL
D_FF = ((8 * D_MODEL // 3 + 255) // 256) * 256
CHUNK = 128
ROPE_THETA = 10000.0
EPS = 1e-6

kernel_name = "hybrid_retention_pool_decoder_step"


def rmsnorm(x, g):
    xf = x.astype(jnp.float32)
    r = xf * lax.rsqrt(jnp.mean(xf * xf, axis=-1, keepdims=True) + EPS)
    return (r * g.astype(jnp.float32)).astype(x.dtype)


def modulate(h, shift, scale):
    return h * (1.0 + scale[:, None, :]) + shift[:, None, :]


def rope(x, pos):
    d = x.shape[-1]
    inv = 1.0 / (ROPE_THETA ** (jnp.arange(0, d, 2, dtype=jnp.float32) / d))
    ang = pos.astype(jnp.float32)[:, None] * inv[None, :]
    cos = jnp.cos(ang)[None, :, None, :]
    sin = jnp.sin(ang)[None, :, None, :]
    xf = x.astype(jnp.float32)
    x1, x2 = xf[..., : d // 2], xf[..., d // 2:]
    return jnp.concatenate([x1 * cos - x2 * sin, x1 * sin + x2 * cos], axis=-1)


def retention(q, k, v, S0):
    B, T, H, _ = q.shape
    C = CHUNK if T % CHUNK == 0 else T
    NC = T // C
    log_gamma = jnp.log(1.0 - 2.0 ** (-5.0 - jnp.arange(H, dtype=jnp.float32)))
    idx = jnp.arange(C, dtype=jnp.float32)
    diff = idx[:, None] - idx[None, :]
    dmask = jnp.where(diff[None] >= 0,
                      jnp.exp(jnp.maximum(diff, 0.0)[None] * log_gamma[:, None, None]), 0.0)
    decay_q = jnp.exp((idx + 1.0)[None, :] * log_gamma[:, None])
    decay_k = jnp.exp((C - 1.0 - idx)[None, :] * log_gamma[:, None])
    decay_c = jnp.exp(C * log_gamma)

    def to_chunks(a):
        return jnp.moveaxis(a.astype(jnp.float32).reshape(B, NC, C, H, a.shape[-1]), 1, 0)

    def step(S, qkv):
        qc, kc, vc = qkv
        s = jnp.einsum('bihd,bjhd->bhij', qc, kc) * dmask[None]
        inner = jnp.einsum('bhij,bjhe->bihe', s, vc)
        cross = jnp.einsum('bihd,bhde->bihe', qc, S) * jnp.transpose(decay_q)[None, :, :, None]
        S_new = S * decay_c[None, :, None, None] + jnp.einsum('bjhd,bjhe,hj->bhde', kc, vc, decay_k)
        return S_new, inner + cross

    S_fin, o = lax.scan(step, S0.astype(jnp.float32), (to_chunks(q), to_chunks(k), to_chunks(v)))
    o = jnp.moveaxis(o, 0, 1).reshape(B, T, H, v.shape[-1])
    return o, S_fin


def pool_mixer(u, buf, n_past, pool_w, pool_scale):
    B, T, _ = u.shape
    xp = jnp.concatenate([buf.astype(u.dtype), u], axis=1).astype(jnp.float32)
    cs = jnp.concatenate([jnp.zeros((B, 1, D_POOL), jnp.float32), jnp.cumsum(xp, axis=1)], axis=1)
    end = cs[:, POOL_BUF + 1:]
    cur = xp[:, POOL_BUF:]
    t = jnp.arange(T)
    outs = []
    for g, w in enumerate(POOL_WINDOWS):
        lo, hi = g * POOL_GC, (g + 1) * POOL_GC
        start = cs[:, POOL_BUF + 1 - w: POOL_BUF + 1 - w + T, lo:hi]
        cnt = jnp.minimum(t + n_past + 1, w).astype(jnp.float32)
        outs.append((end[..., lo:hi] - start) / cnt[None, :, None] - cur[..., lo:hi])
    p = jnp.stack(outs, axis=2)
    y = jnp.einsum('btgc,gcd->btgd', p, pool_w.astype(jnp.float32)).reshape(B, T, D_POOL)
    y = y * pool_scale.astype(jnp.float32)
    new_buf = xp[:, -POOL_BUF:].astype(u.dtype)
    return y, new_buf


def layer(x, c, S0, buf, n_past, norm_mix, norm_ffn, w_ada, b_ada, w_in, ret_gn,
          pool_w, pool_scale, w_out, w_gu, w_down):
    B, T, _ = x.shape
    mod = jax.nn.silu(c) @ w_ada + b_ada
    shift_m, scale_m, gate_m, shift_f, scale_f, gate_f = jnp.split(mod, 6, axis=-1)

    h = modulate(rmsnorm(x, norm_mix), shift_m, scale_m)
    z = h @ w_in
    q, k, v, g, u = jnp.split(z, [D_RET, 2 * D_RET, 3 * D_RET, 4 * D_RET], axis=-1)
    pos = n_past + jnp.arange(T, dtype=jnp.int32)
    q = rope(q.reshape(B, T, H_RET, DK), pos)
    k = rope(k.reshape(B, T, H_RET, DK), pos) * (DK ** -0.5)
    v = v.reshape(B, T, H_RET, DV)
    o, S_new = retention(q, k, v, S0)
    o = rmsnorm(o, ret_gn.reshape(H_RET, DV)).reshape(B, T, D_RET)
    o = (o * jax.nn.silu(g.astype(jnp.float32))).astype(x.dtype)
    p, buf_new = pool_mixer(u, buf, n_past, pool_w, pool_scale)
    mix = jnp.concatenate([o, p.astype(x.dtype)], axis=-1) @ w_out
    x = x + gate_m[:, None, :] * mix

    h2 = modulate(rmsnorm(x, norm_ffn), shift_f, scale_f)
    a, b = jnp.split(h2 @ w_gu, 2, axis=-1)
    x = x + gate_f[:, None, :] * ((jax.nn.silu(a) * b) @ w_down)
    return x, S_new, buf_new


def setup_inputs(seed: int = 0) -> dict:
    key = jax.random.key(seed)
    ks = jax.random.split(key, 20)
    f32 = jnp.float32
    nrm = lambda k, s, sc: jax.random.normal(k, s, f32) * sc
    return {
        "x_prompt": nrm(ks[0], (BATCH, SEQ, D_MODEL), 1.0),
        "x_sample": nrm(ks[1], (DEC_BATCH, DEC_SEQ, D_MODEL), 1.0),
        "c_prompt": nrm(ks[2], (BATCH, D_MODEL), 1.0),
        "c_sample": nrm(ks[3], (DEC_BATCH, D_MODEL), 1.0),
        "state_ret": nrm(ks[4], (DEPTH, DEC_BATCH, H_RET, DK, DV), 1.0),
        "state_pool": nrm(ks[5], (DEPTH, DEC_BATCH, POOL_BUF, D_POOL), 1.0),
        "norm_mix": 1.0 + nrm(ks[6], (DEPTH, D_MODEL), 0.02),
        "norm_ffn": 1.0 + nrm(ks[7], (DEPTH, D_MODEL), 0.02),
        "w_ada": nrm(ks[8], (DEPTH, D_MODEL, 6 * D_MODEL), 0.5 * D_MODEL ** -0.5),
        "b_ada": nrm(ks[9], (DEPTH, 6 * D_MODEL), 0.01),
        "w_in": nrm(ks[10], (DEPTH, D_MODEL, D_IN), D_MODEL ** -0.5),
        "ret_gn": 1.0 + nrm(ks[11], (DEPTH, D_RET), 0.02),
        "pool_w": nrm(ks[12], (DEPTH, N_POOL_GROUPS, POOL_GC, POOL_GC), POOL_GC ** -0.5),
        "pool_scale": 1.0 + nrm(ks[13], (DEPTH, D_POOL), 0.02),
        "w_out": nrm(ks[14], (DEPTH, D_MIX, D_MODEL), D_MIX ** -0.5),
        "w_gu": nrm(ks[15], (DEPTH, D_MODEL, 2 * D_FF), D_MODEL ** -0.5),
        "w_down": nrm(ks[16], (DEPTH, D_FF, D_MODEL), D_FF ** -0.5),
        "final_norm": 1.0 + nrm(ks[17], (D_MODEL,), 0.02),
    }


def reference(x_prompt, x_sample, c_prompt, c_sample, state_ret, state_pool,
              norm_mix, norm_ffn, w_ada, b_ada, w_in, ret_gn, pool_w, pool_scale,
              w_out, w_gu, w_down, final_norm):
    xp, xs = x_prompt, x_sample
    S_p0 = jnp.zeros((BATCH, H_RET, DK, DV), jnp.float32)
    buf_p0 = jnp.zeros((BATCH, POOL_BUF, D_POOL), x_prompt.dtype)
    ret_p, pool_p, ret_s, pool_s = [], [], [], []
    for l in range(DEPTH):
        params = (norm_mix[l], norm_ffn[l], w_ada[l], b_ada[l], w_in[l], ret_gn[l],
                  pool_w[l], pool_scale[l], w_out[l], w_gu[l], w_down[l])
        xp, Sp, bp = layer(xp, c_prompt, S_p0, buf_p0, 0, *params)
        xs, Ss, bs = layer(xs, c_sample, state_ret[l], state_pool[l], PAST_LEN, *params)
        ret_p.append(Sp)
        pool_p.append(bp)
        ret_s.append(Ss)
        pool_s.append(bs)
    y_prompt = rmsnorm(xp, final_norm)
    y_sample = rmsnorm(xs, final_norm)
    new_ret_prompt = jnp.stack(ret_p, axis=0)
    new_pool_prompt = jnp.stack(pool_p, axis=0)
    new_ret_sample = jnp.stack(ret_s, axis=0)
    new_pool_sample = jnp.stack(pool_s, axis=0)
    return (y_prompt, y_sample, new_ret_prompt, new_pool_prompt, new_ret_sample, new_pool_sample)
```

```cpp
#include <hip/hip_runtime.h>
#include <hip/hip_cooperative_groups.h>
#include <cstdio>
namespace cg = cooperative_groups;

#define LAS __attribute__((address_space(3)))
typedef unsigned short bf16_t;
typedef short bf16x8 __attribute__((ext_vector_type(8)));
typedef float f32x4 __attribute__((ext_vector_type(4)));
typedef unsigned u32x2 __attribute__((ext_vector_type(2)));
typedef unsigned u32x4 __attribute__((ext_vector_type(4)));

constexpr int DM = 1024, NB = 8, SEQ = 2048, NL = 4, SB = 128;
constexpr int MP = NB * SEQ;
constexpr int MV = MP + SB;
constexpr int MPAD = 16640;
constexpr int DIN = 2560, DFF = 2816, NCOND = 136, MODW = 6 * DM, MODLD = NL * MODW;
constexpr int LDS_BYTES = 131072;
constexpr int TP = 136;

constexpr size_t O_YP = 0, O_YS = (size_t)MP * DM, O_RETP = O_YS + (size_t)SB * DM,
                 O_POOLP = O_RETP + (size_t)NL * NB * 4 * 128 * 128, O_RETS = O_POOLP + (size_t)NL * NB * 15 * 512,
                 O_POOLS = O_RETS + (size_t)NL * SB * 4 * 128 * 128;

struct P {
    const float *x_prompt, *x_sample, *c_prompt, *c_sample, *state_ret, *state_pool, *norm_mix, *norm_ffn, *w_ada, *b_ada, *w_in, *ret_gn,
        *pool_w, *pool_scale, *w_out, *w_gu, *w_down, *final_norm;
    float* out;
    bf16_t *wt_in, *wt_out, *wt_gu, *wt_down, *wt_ada, *wt_pool, *cb, *hb, *zb, *mixb, *actb;
    float *mod, *x, *U, *cosT, *sinT;
};

__device__ __forceinline__ unsigned cvt_pk_bf16(float lo, float hi) { unsigned r; asm("v_cvt_pk_bf16_f32 %0, %1, %2" : "=v"(r) : "v"(lo), "v"(hi)); return r; }
__device__ __forceinline__ bf16_t f2bf(float f) { return (bf16_t)(cvt_pk_bf16(f, 0.f) & 0xffffu); }
__device__ __forceinline__ float bf2f(bf16_t b) { return __uint_as_float(((unsigned)b) << 16); }
__device__ __forceinline__ float bflo(unsigned u) { return __uint_as_float(u << 16); }
__device__ __forceinline__ float bfhi(unsigned u) { return __uint_as_float(u & 0xffff0000u); }
__device__ __forceinline__ float silu_f(float a) { return a * __builtin_amdgcn_rcpf(1.f + __expf(-a)); }
__device__ __forceinline__ int cond_row(int row) { return row < MP ? (row >> 11) : min(NB + row - MP, NCOND - 1); }
__device__ __forceinline__ f32x4 mfma16(bf16x8 a, bf16x8 b, f32x4 c) { return __builtin_amdgcn_mfma_f32_16x16x32_bf16(a, b, c, 0, 0, 0); }
__device__ __forceinline__ float wave_sum(float v) {
#pragma unroll
    for (int o = 32; o > 0; o >>= 1) v += __shfl_xor(v, o, 64);
    return v;
}

__device__ __forceinline__ int opaque_tid() { int t = threadIdx.x; asm volatile("" : "+v"(t)); return t; }

namespace pg8 {
constexpr int BM = 256, BK = 64, HALF = 128, HTB = HALF * BK * 2, STAGE_BYTES = 8 * HTB, NXCD = 8, WGM = 8;
__host__ __device__ __forceinline__ int lds_byte(int r, int c) { const int st = (r >> 4) * 2 + (c >> 5), rr = r & 15, cc = c & 31, ob = rr * 64 + cc * 2; return st * 1024 + (ob ^ (((ob >> 9) & 1) << 5)); }
__host__ __device__ __forceinline__ void stage_rc(int b, int& R, int& C) { const int st = b / 1024, sb = b % 1024, swz = sb ^ (((sb >> 9) & 1) << 5); R = (st >> 1) * 16 + swz / 64; C = (st & 1) * 32 + (swz % 64) / 2; }
struct Unit { int pm, pn; };
struct Gemm { const bf16_t* A; const bf16_t* Bt; int M, N, K; };
struct StaticOrder {
    int nM, nN, nwg, G, c;
    __device__ void init(int M, int N, int G_, int c_) { nM = M / BM; nN = N / BM; nwg = nM * nN; G = G_; c = c_; }
    __device__ bool next(int i, Unit& u) const {
        const long L = (long)i * G + c; if (L >= nwg) return false;
        int wgid = (int)L; { const int q = nwg / NXCD, r = nwg % NXCD, xcd = wgid % NXCD, off = wgid / NXCD; wgid = (xcd < r ? xcd * (q + 1) : r * (q + 1) + (xcd - r) * q) + off; }
        const int nig = WGM * nN, gid = wgid / nig, fm = gid * WGM, gsz = (nM - fm) < WGM ? (nM - fm) : WGM;
        u.pm = fm + ((wgid % nig) % gsz); u.pn = (wgid % nig) / gsz; return true;
    }
};

template <class Epi>
__device__ __forceinline__ void gemm_phase(LAS unsigned char* lds, const Gemm g, const StaticOrder& S, const Epi& E) {
    const int tid = opaque_tid(), wid = __builtin_amdgcn_readfirstlane(tid >> 6), lane = tid & 63, wr = wid >> 2, wc = wid & 3, fr = lane & 15, fq = lane >> 4;
    const int K = g.K, nt = K / BK;
    unsigned voffA[2];
#pragma unroll
    for (int i = 0; i < 2; ++i) { int R, C; stage_rc(tid * 16 + i * 8192, R, C); voffA[i] = (unsigned)(R * K + C) * 2u; }
    const size_t kstep = (size_t)(BK * 2);
    const size_t hstep = (size_t)HALF * K * 2;
    const size_t tstep = 2 * hstep;
    const unsigned ldsw = (unsigned)wid * 1024u;
    const int aoff = lds_byte(wr * 64 + fr, fq * 8), boff = lds_byte(wc * 32 + fr, fq * 8);
#define PG8_SA(b, h) (((b) * 2 + (h)) * HTB)
#define PG8_SB(b, h) ((4 + (b) * 2 + (h)) * HTB)
#define PG8_STAGE(bufoff, gbase) do { _Pragma("unroll") for (int _i = 0; _i < 2; ++_i) \
        __builtin_amdgcn_global_load_lds((const unsigned*)((const char*)(gbase) + voffA[_i]), (LAS unsigned*)(lds + (bufoff) + ldsw + _i * 8192), 16, 0, 0); } while (0)
#define PG8_LDA(dst, b, h) do { _Pragma("unroll") for (int m = 0; m < 4; ++m) _Pragma("unroll") for (int k = 0; k < 2; ++k) dst[m][k] = *(const LAS bf16x8*)(lds + PG8_SA(b, h) + aoff + m * 2048 + k * 1024); } while (0)
#define PG8_LDB(dst, b, h) do { _Pragma("unroll") for (int n = 0; n < 2; ++n) _Pragma("unroll") for (int k = 0; k < 2; ++k) dst[n][k] = *(const LAS bf16x8*)(lds + PG8_SB(b, h) + boff + n * 2048 + k * 1024); } while (0)
#define PG8_MMA(ai, bj, At, Bt) do { __builtin_amdgcn_s_setprio(1); _Pragma("unroll") for (int m = 0; m < 4; ++m) _Pragma("unroll") for (int n = 0; n < 2; ++n) _Pragma("unroll") for (int k = 0; k < 2; ++k) \
        acc[ai][bj][m][n] = __builtin_amdgcn_mfma_f32_16x16x32_bf16(Bt[n][k], At[m][k], acc[ai][bj][m][n], 0, 0, 0); __builtin_amdgcn_s_setprio(0); } while (0)
#define PG8_WAIT_V(n) asm volatile("s_waitcnt vmcnt(" #n ")" ::: "memory")
#define PG8_WAIT_L(n) asm volatile("s_waitcnt lgkmcnt(" #n ")" ::: "memory")
#define PG8_BAR __builtin_amdgcn_s_barrier()
#define PG8_SCHED __builtin_amdgcn_sched_barrier(0)
    Unit cur, nxt; int ui = 0;
    if (!S.next(0, cur)) return;
    f32x4 acc[2][2][4][2];
#pragma unroll
    for (int a = 0; a < 2; ++a)
#pragma unroll
        for (int b = 0; b < 2; ++b)
#pragma unroll
            for (int m = 0; m < 4; ++m)
#pragma unroll
                for (int n = 0; n < 2; ++n) acc[a][b][m][n] = (f32x4){0.f, 0.f, 0.f, 0.f};
    bf16x8 At[4][2], B0[2][2], B1[2][2];
    const char* cA = (const char*)g.A + (size_t)cur.pm * tstep; const char* cB = (const char*)g.Bt + (size_t)cur.pn * tstep;
    PG8_STAGE(PG8_SB(0, 0), cB); PG8_STAGE(PG8_SA(0, 0), cA); PG8_STAGE(PG8_SB(0, 1), cB + hstep); PG8_STAGE(PG8_SA(0, 1), cA + hstep);
    if (wr == 1) PG8_BAR;
    PG8_WAIT_V(4); PG8_BAR;
    PG8_STAGE(PG8_SB(1, 0), cB + kstep); PG8_STAGE(PG8_SA(1, 0), cA + kstep); PG8_STAGE(PG8_SB(1, 1), cB + hstep + kstep);
    PG8_WAIT_V(6); PG8_BAR;
    for (;;) {
        const bool has_next = S.next(ui + 1, nxt);
        const char* nA = has_next ? (const char*)g.A + (size_t)nxt.pm * tstep : cA; const char* nB = has_next ? (const char*)g.Bt + (size_t)nxt.pn * tstep : cB;
        for (int t = 0; t < nt; t += 2) {
            const bool last = (t == nt - 2);
            const char* a1 = cA + (size_t)(t + 1) * kstep;
            const char* a2 = last ? nA : cA + (size_t)(t + 2) * kstep; const char* b2 = last ? nB : cB + (size_t)(t + 2) * kstep;
            const char* a3 = a2 + kstep; const char* b3 = b2 + kstep;
            PG8_LDB(B0, 0, 0); PG8_SCHED; PG8_LDA(At, 0, 0); PG8_STAGE(PG8_SA(1, 1), a1 + hstep);
            PG8_WAIT_L(8); PG8_BAR; PG8_WAIT_L(0); PG8_MMA(0, 0, At, B0); PG8_BAR; PG8_SCHED;
            PG8_LDB(B1, 0, 1); PG8_STAGE(PG8_SB(0, 0), b2);
            PG8_BAR; PG8_WAIT_L(0); PG8_MMA(0, 1, At, B1); PG8_BAR;
            PG8_LDA(At, 0, 1); PG8_STAGE(PG8_SA(0, 0), a2);
            PG8_BAR; PG8_WAIT_L(0); PG8_MMA(1, 0, At, B0); PG8_BAR; PG8_SCHED;
            PG8_STAGE(PG8_SB(0, 1), b2 + hstep);
            PG8_WAIT_V(6); PG8_BAR; PG8_MMA(1, 1, At, B1); PG8_BAR;
            PG8_LDB(B0, 1, 0); PG8_SCHED; PG8_LDA(At, 1, 0); PG8_STAGE(PG8_SA(0, 1), a2 + hstep);
            PG8_WAIT_L(8); PG8_BAR; PG8_WAIT_L(0); PG8_MMA(0, 0, At, B0); PG8_BAR; PG8_SCHED;
            PG8_LDB(B1, 1, 1); PG8_STAGE(PG8_SB(1, 0), b3);
            PG8_BAR; PG8_WAIT_L(0); PG8_MMA(0, 1, At, B1); PG8_BAR;
            PG8_LDA(At, 1, 1); PG8_STAGE(PG8_SA(1, 0), a3);
            PG8_BAR; PG8_WAIT_L(0); PG8_MMA(1, 0, At, B0); PG8_BAR; PG8_SCHED;
            PG8_STAGE(PG8_SB(1, 1), b3 + hstep);
            PG8_WAIT_V(6); PG8_BAR; PG8_MMA(1, 1, At, B1); PG8_BAR;
        }
        E(acc, cur, wr, wc, fr, fq);
        if (!has_next) break;
#pragma unroll
        for (int a = 0; a < 2; ++a)
#pragma unroll
            for (int b = 0; b < 2; ++b)
#pragma unroll
                for (int m = 0; m < 4; ++m)
#pragma unroll
                    for (int n = 0; n < 2; ++n) acc[a][b][m][n] = (f32x4){0.f, 0.f, 0.f, 0.f};
        cur = nxt; cA = nA; cB = nB; ++ui;
    }
    PG8_WAIT_V(0);
    if (wr == 0) PG8_BAR;
    PG8_BAR;
#undef PG8_SA
#undef PG8_SB
#undef PG8_STAGE
#undef PG8_LDA
#undef PG8_LDB
#undef PG8_MMA
#undef PG8_WAIT_V
#undef PG8_WAIT_L
#undef PG8_BAR
#undef PG8_SCHED
}
}
using pg8::Unit;
typedef f32x4 Acc[2][2][4][2];

struct EpiMod {
    float* mod; const float* bias;
    __device__ __forceinline__ void operator()(const Acc& acc, const Unit& u, int wr, int wc, int fr, int fq) const {
        const int row0 = wr * 64 + fr, col0 = u.pn * 256 + wc * 32 + 4 * fq;
#pragma unroll
        for (int ai = 0; ai < 2; ++ai)
#pragma unroll
            for (int m = 0; m < 4; ++m) { const int row = row0 + ai * 128 + m * 16; if (row < NCOND) {
#pragma unroll
                for (int bj = 0; bj < 2; ++bj)
#pragma unroll
                    for (int n = 0; n < 2; ++n) { const int c = col0 + bj * 128 + n * 16; *(f32x4*)(mod + (size_t)row * MODLD + c) = acc[ai][bj][m][n] + *(const f32x4*)(bias + c); } } }
    }
};
struct EpiIn {
    bf16_t* zb; const float* cosT; const float* sinT; float* poolp; float* pools;
    __device__ __forceinline__ void operator()(const Acc& acc, const Unit& u, int wr, int wc, int fr, int fq) const {
        const int pn = u.pn, row0 = u.pm * 256 + wr * 64 + fr;
        if (pn < 4) {
            const float sc = (pn >= 2) ? 0.08838834764831845f : 1.f;
            const int i0 = 16 * wc + 4 * fq;
#pragma unroll
            for (int ai = 0; ai < 2; ++ai)
#pragma unroll
                for (int m = 0; m < 4; ++m) {
                    const int row = row0 + ai * 128 + m * 16; const int pi = row < MP ? (row & 2047) : 2048;
                    const f32x4 cs = *(const f32x4*)(cosT + pi * 64 + i0) * sc, sn = *(const f32x4*)(sinT + pi * 64 + i0) * sc;
#pragma unroll
                    for (int bj = 0; bj < 2; ++bj) {
                        const f32x4 x1 = acc[ai][bj][m][0], x2 = acc[ai][bj][m][1];
                        const f32x4 o1 = x1 * cs - x2 * sn, o2 = x1 * sn + x2 * cs;
                        bf16_t* dst = zb + (size_t)row * DIN + pn * 256 + bj * 128 + i0;
                        u32x2 w1, w2; w1.x = cvt_pk_bf16(o1[0], o1[1]); w1.y = cvt_pk_bf16(o1[2], o1[3]); w2.x = cvt_pk_bf16(o2[0], o2[1]); w2.y = cvt_pk_bf16(o2[2], o2[3]);
                        *(u32x2*)dst = w1; *(u32x2*)(dst + 64) = w2;
                    }
                }
        } else {
#pragma unroll
            for (int ai = 0; ai < 2; ++ai)
#pragma unroll
                for (int m = 0; m < 4; ++m) {
                    const int row = row0 + ai * 128 + m * 16;
#pragma unroll
                    for (int bj = 0; bj < 2; ++bj) {
                        const f32x4 v0 = acc[ai][bj][m][0], v1 = acc[ai][bj][m][1];
                        const int col = pn * 256 + bj * 128 + wc * 32 + 8 * fq;
                        u32x4 w; w.x = cvt_pk_bf16(v0[0], v0[1]); w.y = cvt_pk_bf16(v0[2], v0[3]); w.z = cvt_pk_bf16(v1[0], v1[1]); w.w = cvt_pk_bf16(v1[2], v1[3]);
                        *(u32x4*)(zb + (size_t)row * DIN + col) = w;
                        if (pn >= 8) {
                            float* dst = nullptr;
                            if (row < MP) { const int t = row & 2047; if (t >= SEQ - 15) dst = poolp + ((size_t)((row >> 11) * 15 + (t - (SEQ - 15)))) * 512 + (col - 2048); }
                            else if (row < MV) dst = pools + ((size_t)((row - MP) * 15 + 14)) * 512 + (col - 2048);
                            if (dst) { *(f32x4*)dst = v0; *(f32x4*)(dst + 4) = v1; }
                        }
                    }
                }
        }
    }
};
struct EpiRes {
    float* x; const float* gate;
    __device__ __forceinline__ void operator()(const Acc& acc, const Unit& u, int wr, int wc, int fr, int fq) const {
        const int row0 = u.pm * 256 + wr * 64 + fr, col0 = u.pn * 256 + wc * 32 + 4 * fq;
#pragma unroll
        for (int ai = 0; ai < 2; ++ai)
#pragma unroll
            for (int m = 0; m < 4; ++m) {
                const int row = row0 + ai * 128 + m * 16; const float* gr = gate + (size_t)cond_row(row) * MODLD; float* xr = x + (size_t)row * DM;
#pragma unroll
                for (int bj = 0; bj < 2; ++bj)
#pragma unroll
                    for (int n = 0; n < 2; ++n) { const int c = col0 + bj * 128 + n * 16; *(f32x4*)(xr + c) = *(const f32x4*)(xr + c) + *(const f32x4*)(gr + c) * acc[ai][bj][m][n]; }
            }
    }
};
struct EpiGu {
    bf16_t* act;
    __device__ __forceinline__ void operator()(const Acc& acc, const Unit& u, int wr, int wc, int fr, int fq) const {
        const int row0 = u.pm * 256 + wr * 64 + fr, col = u.pn * 128 + wc * 32 + 8 * fq;
#pragma unroll
        for (int ai = 0; ai < 2; ++ai)
#pragma unroll
            for (int m = 0; m < 4; ++m) {
                const int row = row0 + ai * 128 + m * 16;
                float r[8];
#pragma unroll
                for (int n = 0; n < 2; ++n)
#pragma unroll
                    for (int j = 0; j < 4; ++j) r[n * 4 + j] = silu_f(acc[ai][0][m][n][j]) * acc[ai][1][m][n][j];
                u32x4 w; w.x = cvt_pk_bf16(r[0], r[1]); w.y = cvt_pk_bf16(r[2], r[3]); w.z = cvt_pk_bf16(r[4], r[5]); w.w = cvt_pk_bf16(r[6], r[7]);
                *(u32x4*)(act + (size_t)row * DFF + col) = w;
            }
    }
};

__device__ __forceinline__ int orig_col(int mode, int np) {
    if (mode == 0) return np;
    const int perm8 = (np & ~31) + 8 * ((np >> 2) & 3) + 4 * ((np >> 4) & 1) + (np & 3);
    if (mode == 1) return perm8;
    if (mode == 2) {
        if (np >= 1024) return perm8;
        const int c = np & 127; return (np & ~127) + 64 * ((c >> 4) & 1) + 16 * (c >> 5) + (c & 15);
    }
    const int pn = np >> 8, c = np & 255, bj = c >> 7, wc = (c >> 5) & 3, n = (c >> 4) & 1, fq = (c >> 2) & 3, j = c & 3;
    return bj * DFF + pn * 128 + 32 * wc + 8 * fq + 4 * n + j;
}
__device__ void prep_phase(const P& p, unsigned char* shm) {
    float(*tile)[65] = (float(*)[65])shm;
    const int tid = opaque_tid();
    constexpr int T_IN = 40 * 16, T_OUT = 16 * 16, T_GU = 88 * 16, T_DN = 16 * 44, T_ADA = 96 * 16, T_POOL = 4;
    constexpr int TOT = NL * (T_IN + T_OUT + T_GU + T_DN + T_ADA) + 16 * T_POOL;
    for (int it = blockIdx.x; it < TOT; it += gridDim.x) {
        int r = it, tl, K, N, mode; const float* src; bf16_t* dst;
        if (r < NL * T_IN) { const int l = r / T_IN; tl = r % T_IN; K = 1024; N = DIN; mode = 2; src = p.w_in + (size_t)l * K * N; dst = p.wt_in + (size_t)l * K * N; }
        else if ((r -= NL * T_IN) < NL * T_OUT) { const int l = r / T_OUT; tl = r % T_OUT; K = 1024; N = 1024; mode = 0; src = p.w_out + (size_t)l * K * N; dst = p.wt_out + (size_t)l * K * N; }
        else if ((r -= NL * T_OUT) < NL * T_GU) { const int l = r / T_GU; tl = r % T_GU; K = 1024; N = 2 * DFF; mode = 3; src = p.w_gu + (size_t)l * K * N; dst = p.wt_gu + (size_t)l * K * N; }
        else if ((r -= NL * T_GU) < NL * T_DN) { const int l = r / T_DN; tl = r % T_DN; K = DFF; N = 1024; mode = 0; src = p.w_down + (size_t)l * K * N; dst = p.wt_down + (size_t)l * K * N; }
        else if ((r -= NL * T_DN) < NL * T_ADA) { const int l = r / T_ADA; tl = r % T_ADA; K = 1024; N = MODW; mode = 0; src = p.w_ada + (size_t)l * K * N; dst = p.wt_ada + (size_t)l * K * N; }
        else { r -= NL * T_ADA; const int mtx = r / T_POOL; tl = r % T_POOL; K = 128; N = 128; mode = 0; src = p.pool_w + (size_t)mtx * 16384; dst = p.wt_pool + (size_t)mtx * 16384; }
        const int nkt = K / 64, ntile = tl / nkt, kt = tl % nkt;
        { const int nn = tid & 63, oc = orig_col(mode, ntile * 64 + nn);
#pragma unroll
          for (int i = 0; i < 8; ++i) { const int kk = i * 8 + (tid >> 6); tile[kk][nn] = src[(size_t)(kt * 64 + kk) * N + oc]; } }
        __syncthreads();
        { const int k2 = (tid & 31) * 2;
#pragma unroll
          for (int i = 0; i < 4; ++i) { const int nn = i * 16 + (tid >> 5); *(unsigned*)(dst + (size_t)(ntile * 64 + nn) * K + kt * 64 + k2) = cvt_pk_bf16(tile[k2][nn], tile[k2 + 1][nn]); } }
        __syncthreads();
    }
    const size_t gtid = (size_t)blockIdx.x * 512 + tid, gsz = (size_t)gridDim.x * 512;
    for (size_t i = gtid; i < (size_t)MPAD * 256; i += gsz) {
        const size_t row = i >> 8; f32x4 v = (f32x4){0.f, 0.f, 0.f, 0.f};
        if (row < MP) v = ((const f32x4*)p.x_prompt)[i]; else if (row < MV) v = ((const f32x4*)p.x_sample)[i - (size_t)MP * 256];
        ((f32x4*)p.x)[i] = v;
    }
    for (size_t i = gtid; i < (size_t)256 * 512; i += gsz) {
        const int row = (int)(i >> 9), c2 = (int)(i & 511) * 2; float a = 0.f, b = 0.f;
        if (row < NB) { a = p.c_prompt[row * DM + c2]; b = p.c_prompt[row * DM + c2 + 1]; }
        else if (row < NCOND) { a = p.c_sample[(row - NB) * DM + c2]; b = p.c_sample[(row - NB) * DM + c2 + 1]; }
        *(unsigned*)(p.cb + (size_t)row * DM + c2) = cvt_pk_bf16(silu_f(a), silu_f(b));
    }
    for (size_t i = gtid; i < (size_t)2049 * 64; i += gsz) {
        const int pi = (int)(i >> 6), k = (int)(i & 63); const float pos = pi < 2048 ? (float)pi : 16384.f;
        const float inv = 1.0f / exp2f((float)k * (13.287712379549449f / 64.f));
        const float angf = pos * inv; const double a = (double)angf;
        const double kq = rint(a * 0.63661977236758134308);
        double y = fma(-kq, 1.57079632679489655800e+00, a); y = fma(-kq, 6.12323399573676603587e-17, y);
        const double y2 = y * y;
        const double sy = y * (1.0 + y2 * (-1.0 / 6 + y2 * (1.0 / 120 + y2 * (-1.0 / 5040 + y2 * (1.0 / 362880 + y2 * (-1.0 / 39916800 + y2 * (1.0 / 6227020800.0)))))));
        const double cy = 1.0 + y2 * (-0.5 + y2 * (1.0 / 24 + y2 * (-1.0 / 720 + y2 * (1.0 / 40320 + y2 * (-1.0 / 3628800 + y2 * (1.0 / 479001600.0))))));
        const int q = ((int)((long long)kq)) & 3;
        const double s = (q == 0) ? sy : (q == 1) ? cy : (q == 2) ? -sy : -cy;
        const double c = (q == 0) ? cy : (q == 1) ? -sy : (q == 2) ? -cy : sy;
        p.cosT[i] = (float)c; p.sinT[i] = (float)s;
    }
    for (size_t i = gtid; i < (size_t)NL * SB * 14 * 128; i += gsz) {
        const size_t c4 = i & 127, r = (i >> 7) % 14, lb = (i >> 7) / 14;
        ((f32x4*)(p.out + O_POOLS))[(lb * 15 + r) * 128 + c4] = ((const f32x4*)p.state_pool)[(lb * 15 + r + 1) * 128 + c4];
    }
}

__device__ void norm_phase(const P& p, int l, int which) {
    const float* g = (which ? p.norm_ffn : p.norm_mix) + l * DM;
    const int shift_off = l * MODW + (which ? 3 * DM : 0), scale_off = shift_off + DM;
    const int tid_ = opaque_tid(); const int wave = tid_ >> 6, lane = tid_ & 63;
    for (int row = blockIdx.x * 8 + wave; row < MPAD; row += gridDim.x * 8) {
        const f32x4* xr = (const f32x4*)(p.x + (size_t)row * DM);
        f32x4 v[4]; float ss = 0.f;
#pragma unroll
        for (int i = 0; i < 4; ++i) { v[i] = xr[lane + 64 * i]; ss += v[i][0] * v[i][0] + v[i][1] * v[i][1] + v[i][2] * v[i][2] + v[i][3] * v[i][3]; }
        ss = wave_sum(ss);
        const float rstd = rsqrtf(ss * (1.f / DM) + 1e-6f);
        const float* mr = p.mod + (size_t)cond_row(row) * MODLD;
#pragma unroll
        for (int i = 0; i < 4; ++i) {
            const int col = 4 * (lane + 64 * i);
            const f32x4 gg = *(const f32x4*)(g + col), sc = *(const f32x4*)(mr + scale_off + col), sh = *(const f32x4*)(mr + shift_off + col);
            const f32x4 h = v[i] * rstd * gg * (sc + 1.f) + sh;
            u32x2 w; w.x = cvt_pk_bf16(h[0], h[1]); w.y = cvt_pk_bf16(h[2], h[3]);
            *(u32x2*)(p.hb + (size_t)row * DM + col) = w;
        }
    }
}
__device__ void final_norm_phase(const P& p) {
    const int tid_ = opaque_tid(); const int wave = tid_ >> 6, lane = tid_ & 63;
    for (int row = blockIdx.x * 8 + wave; row < MV; row += gridDim.x * 8) {
        const f32x4* xr = (const f32x4*)(p.x + (size_t)row * DM);
        f32x4 v[4]; float ss = 0.f;
#pragma unroll
        for (int i = 0; i < 4; ++i) { v[i] = xr[lane + 64 * i]; ss += v[i][0] * v[i][0] + v[i][1] * v[i][1] + v[i][2] * v[i][2] + v[i][3] * v[i][3]; }
        ss = wave_sum(ss);
        const float rstd = rsqrtf(ss * (1.f / DM) + 1e-6f);
        float* o = p.out + (size_t)row * DM;
#pragma unroll
        for (int i = 0; i < 4; ++i) { const int col = 4 * (lane + 64 * i); *(f32x4*)(o + col) = v[i] * rstd * *(const f32x4*)(p.final_norm + col); }
    }
}

__device__ __forceinline__ float log2_gamma(int h) { return log2f(1.f - exp2f(-5.f - (float)h)); }

__device__ void u_unit(const P& p, int unit, unsigned char* shm) {
    const int b = unit >> 6, h = (unit >> 4) & 3, c = unit & 15;
    bf16_t* VT = (bf16_t*)shm; bf16_t* KT = VT + 128 * TP;
    const int tid = opaque_tid(), w = tid >> 6, lane = tid & 63, fr = lane & 15, fq = lane >> 4;
    const float lg = log2_gamma(h);
    const size_t rowbase = (size_t)b * SEQ + c * 128;
    {
        const int t = (w & 1) * 64 + lane; const float dk = exp2f((float)(127 - t) * lg);
        const bf16_t* zr = p.zb + (rowbase + t) * DIN + h * 128;
#pragma unroll
        for (int i = 0; i < 4; ++i) {
            const int d0 = (w >> 1) * 32 + 8 * i;
            const u32x4 kk = *(const u32x4*)(zr + 512 + d0), vv = *(const u32x4*)(zr + 1024 + d0);
#pragma unroll
            for (int j = 0; j < 4; ++j) {
                KT[(d0 + 2 * j) * TP + t] = (bf16_t)(kk[j] & 0xffffu); KT[(d0 + 2 * j + 1) * TP + t] = (bf16_t)(kk[j] >> 16);
                VT[(d0 + 2 * j) * TP + t] = f2bf(bflo(vv[j]) * dk); VT[(d0 + 2 * j + 1) * TP + t] = f2bf(bfhi(vv[j]) * dk);
            }
        }
    }
    __syncthreads();
    bf16x8 a[4];
#pragma unroll
    for (int s = 0; s < 4; ++s) a[s] = *(const bf16x8*)(VT + (16 * w + fr) * TP + 32 * s + 8 * fq);
    float* Ud = p.U + (size_t)unit * 16384 + (16 * w + fr) * 128;
#pragma unroll
    for (int n = 0; n < 8; ++n) {
        f32x4 acc = (f32x4){0.f, 0.f, 0.f, 0.f};
#pragma unroll
        for (int s = 0; s < 4; ++s) acc = mfma16(*(const bf16x8*)(KT + (16 * n + fr) * TP + 32 * s + 8 * fq), a[s], acc);
        *(f32x4*)(Ud + 16 * n + 4 * fq) = acc;
    }
    __syncthreads();
}

__device__ void o_unit(const P& p, int l, int unit, unsigned char* shm) {
    const int b = unit >> 6, h = (unit >> 4) & 3, c = unit & 15;
    bf16_t* Ks = (bf16_t*)shm; bf16_t* VT = Ks + 128 * TP; bf16_t* ST = VT + 128 * TP;
    const int tid = opaque_tid(), w = tid >> 6, lane = tid & 63, fr = lane & 15, fq = lane >> 4;
    const float lg = log2_gamma(h), gC = exp2f(128.f * lg);
    const size_t rowbase = (size_t)b * SEQ + c * 128;
#pragma unroll
    for (int i = 0; i < 4; ++i) {
        const int q = tid + 512 * i, row = q >> 4, ch = q & 15;
        *(u32x4*)(Ks + row * TP + ch * 8) = *(const u32x4*)(p.zb + (rowbase + row) * DIN + 512 + h * 128 + ch * 8);
    }
    {
        const int t = (w & 1) * 64 + lane; const bf16_t* zr = p.zb + (rowbase + t) * DIN + 1024 + h * 128;
#pragma unroll
        for (int i = 0; i < 4; ++i) {
            const int e0 = (w >> 1) * 32 + 8 * i; const u32x4 vv = *(const u32x4*)(zr + e0);
#pragma unroll
            for (int j = 0; j < 4; ++j) { VT[(e0 + 2 * j) * TP + t] = (bf16_t)(vv[j] & 0xffffu); VT[(e0 + 2 * j + 1) * TP + t] = (bf16_t)(vv[j] >> 16); }
        }
    }
    {
        f32x4 s4[8];
#pragma unroll
        for (int i = 0; i < 8; ++i) s4[i] = (f32x4){0.f, 0.f, 0.f, 0.f};
        const float* Ub = p.U + (size_t)(unit - c) * 16384;
        for (int j = 0; j < c; ++j) {
            const f32x4* Uj = (const f32x4*)(Ub + (size_t)j * 16384);
#pragma unroll
            for (int i = 0; i < 8; ++i) s4[i] = s4[i] * gC + Uj[tid + 512 * i];
        }
#pragma unroll
        for (int i = 0; i < 8; ++i) {
            const int f = tid + 512 * i, e = f >> 5, d0 = (f & 31) * 4;
            u32x2 wv; wv.x = cvt_pk_bf16(s4[i][0], s4[i][1]); wv.y = cvt_pk_bf16(s4[i][2], s4[i][3]);
            *(u32x2*)(ST + e * TP + d0) = wv;
        }
        if (c == 15) {
            const f32x4* Uj = (const f32x4*)(Ub + (size_t)15 * 16384);
            float* dst = p.out + O_RETP + ((size_t)(l * NB + b) * 4 + h) * 16384;
#pragma unroll
            for (int i = 0; i < 8; ++i) {
                const int f = tid + 512 * i, e = f >> 5, d0 = (f & 31) * 4; const f32x4 fin = s4[i] * gC + Uj[f];
#pragma unroll
                for (int jj = 0; jj < 4; ++jj) dst[(d0 + jj) * 128 + e] = fin[jj];
            }
        }
    }
    __syncthreads();
    const int il = 16 * w + fr;
    bf16x8 aq[4];
    { const bf16_t* qr = p.zb + (rowbase + il) * DIN + h * 128 + 8 * fq;
#pragma unroll
      for (int s = 0; s < 4; ++s) aq[s] = *(const bf16x8*)(qr + 32 * s); }
    bf16x8 pf[4];
#pragma unroll
    for (int sp = 0; sp < 4; ++sp) {
        f32x4 a0 = (f32x4){0.f, 0.f, 0.f, 0.f}, a1 = a0;
#pragma unroll
        for (int s = 0; s < 4; ++s) {
            a0 = mfma16(*(const bf16x8*)(Ks + (32 * sp + fr) * TP + 32 * s + 8 * fq), aq[s], a0);
            a1 = mfma16(*(const bf16x8*)(Ks + (32 * sp + 16 + fr) * TP + 32 * s + 8 * fq), aq[s], a1);
        }
        float v0[4], v1[4];
#pragma unroll
        for (int jj = 0; jj < 4; ++jj) {
            const int d0 = il - (32 * sp + 4 * fq + jj), d1 = d0 - 16;
            v0[jj] = d0 >= 0 ? a0[jj] * exp2f((float)d0 * lg) : 0.f;
            v1[jj] = d1 >= 0 ? a1[jj] * exp2f((float)d1 * lg) : 0.f;
        }
        u32x4 pk; pk.x = cvt_pk_bf16(v0[0], v0[1]); pk.y = cvt_pk_bf16(v0[2], v0[3]); pk.z = cvt_pk_bf16(v1[0], v1[1]); pk.w = cvt_pk_bf16(v1[2], v1[3]);
        pf[sp] = __builtin_bit_cast(bf16x8, pk);
    }
    const float dq = exp2f((float)(il + 1) * lg);
    f32x4 o[8]; float ss = 0.f;
#pragma unroll
    for (int ne = 0; ne < 8; ++ne) {
        f32x4 ai = (f32x4){0.f, 0.f, 0.f, 0.f}, ac = ai;
        const bf16_t* vr = VT + (16 * ne + fr) * TP + 4 * fq; const bf16_t* sr = ST + (16 * ne + fr) * TP + 8 * fq;
#pragma unroll
        for (int s = 0; s < 4; ++s) {
            const u32x2 lo = *(const u32x2*)(vr + 32 * s), hi = *(const u32x2*)(vr + 32 * s + 16);
            u32x4 bv; bv.x = lo.x; bv.y = lo.y; bv.z = hi.x; bv.w = hi.y;
            ai = mfma16(__builtin_bit_cast(bf16x8, bv), pf[s], ai);
            ac = mfma16(*(const bf16x8*)(sr + 32 * s), aq[s], ac);
        }
        o[ne] = ai + ac * dq;
        ss += o[ne][0] * o[ne][0] + o[ne][1] * o[ne][1] + o[ne][2] * o[ne][2] + o[ne][3] * o[ne][3];
    }
    ss += __shfl_xor(ss, 16, 64); ss += __shfl_xor(ss, 32, 64);
    const float rstd = rsqrtf(ss * (1.f / 128.f) + 1e-6f);
    const bf16_t* gr = p.zb + (rowbase + il) * DIN + 1536 + h * 128 + 4 * fq;
    bf16_t* mr = p.mixb + (rowbase + il) * DM + h * 128 + 4 * fq;
    const float* gn = p.ret_gn + l * 512 + h * 128 + 4 * fq;
#pragma unroll
    for (int ne = 0; ne < 8; ++ne) {
        const u32x2 gg = *(const u32x2*)(gr + 16 * ne); const f32x4 g4 = *(const f32x4*)(gn + 16 * ne);
        const float r0 = o[ne][0] * rstd * g4[0] * silu_f(bflo(gg.x)), r1 = o[ne][1] * rstd * g4[1] * silu_f(bfhi(gg.x)),
                    r2 = o[ne][2] * rstd * g4[2] * silu_f(bflo(gg.y)), r3 = o[ne][3] * rstd * g4[3] * silu_f(bfhi(gg.y));
        u32x2 wv; wv.x = cvt_pk_bf16(r0, r1); wv.y = cvt_pk_bf16(r2, r3);
        *(u32x2*)(mr + 16 * ne) = wv;
    }
    __syncthreads();
}

__device__ void sret_unit(const P& p, int l, int unit, unsigned char* shm) {
    const int b = unit >> 2, h = unit & 3, tid = opaque_tid();
    float* red = (float*)shm; float* qs = red + 16 * 128; float* ks = qs + 128; float* vs = ks + 128; float* red2 = vs + 128;
    const float gam = 1.f - exp2f(-5.f - (float)h);
    const size_t row = (size_t)MP + b; const bf16_t* zr = p.zb + row * DIN + h * 128;
    if (tid < 128) { qs[tid] = bf2f(zr[tid]); ks[tid] = bf2f(zr[512 + tid]); vs[tid] = bf2f(zr[1024 + tid]); }
    __syncthreads();
    const int e0 = (tid & 31) * 4, dg = tid >> 5;
    const size_t so = ((size_t)(l * SB + b) * 4 + h) * 16384;
    const float* S0 = p.state_ret + so; float* Sn = p.out + O_RETS + so;
    const f32x4 v4 = *(const f32x4*)(vs + e0); f32x4 po = (f32x4){0.f, 0.f, 0.f, 0.f};
#pragma unroll
    for (int i = 0; i < 8; ++i) {
        const int d = dg + 16 * i; const f32x4 s = *(const f32x4*)(S0 + d * 128 + e0);
        po += s * qs[d]; *(f32x4*)(Sn + d * 128 + e0) = s * gam + v4 * ks[d];
    }
    *(f32x4*)(red + dg * 128 + e0) = po;
    __syncthreads();
    float o = 0.f;
    if (tid < 128) {
        float sum = 0.f, qk = 0.f;
#pragma unroll
        for (int g = 0; g < 16; ++g) sum += red[g * 128 + tid];
        for (int d = 0; d < 128; ++d) qk += qs[d] * ks[d];
        o = qk * vs[tid] + gam * sum;
        const float ssw = wave_sum(o * o);
        if ((tid & 63) == 0) red2[tid >> 6] = ssw;
    }
    __syncthreads();
    if (tid < 128) {
        const float rstd = rsqrtf((red2[0] + red2[1]) * (1.f / 128.f) + 1e-6f);
        const float g = bf2f(zr[1536 + tid]);
        p.mixb[row * DM + h * 128 + tid] = f2bf(o * rstd * p.ret_gn[l * 512 + h * 128 + tid] * silu_f(g));
    }
    __syncthreads();
}

__device__ void pool_unit(const P& p, int l, int unit, bool sample, unsigned char* shm) {
    bf16_t* us = (bf16_t*)shm; bf16_t* As = us + 143 * 128; bf16_t* Bs = As + 128 * TP;
    const int tid = opaque_tid(), w = tid >> 6, lane = tid & 63, fr = lane & 15, fq = lane >> 4;
    int g, b = 0, t0 = 0; size_t rowbase;
    if (sample) { g = unit; rowbase = MP; } else { g = unit & 3; const int tt = (unit >> 2) & 15; b = unit >> 6; t0 = tt * 128; rowbase = (size_t)b * SEQ + t0; }
    const int win = 2 << g;
    {
        const bf16_t* wsrc = p.wt_pool + (size_t)(l * 4 + g) * 16384;
#pragma unroll
        for (int i = 0; i < 4; ++i) { const int q = tid + 512 * i, row = q >> 4, ch = q & 15; *(u32x4*)(Bs + row * TP + ch * 8) = *(const u32x4*)(wsrc + row * 128 + ch * 8); }
    }
    const int c = tid & 127, qd = tid >> 7;
    if (!sample) {
        for (int q = tid; q < 143 * 16; q += 512) {
            const int r = q >> 4, ch = q & 15, t = t0 - 15 + r; u32x4 v = (u32x4){0u, 0u, 0u, 0u};
            if (t >= 0) v = *(const u32x4*)(p.zb + ((size_t)b * SEQ + t) * DIN + 2048 + g * 128 + ch * 8);
            *(u32x4*)(us + r * 128 + ch * 8) = v;
        }
        __syncthreads();
        float sum = 0.f;
        for (int i = 1; i < win; ++i) sum += bf2f(us[(15 + 32 * qd - i) * 128 + c]);
        for (int tl = 32 * qd; tl < 32 * qd + 32; ++tl) {
            const float cur = bf2f(us[(15 + tl) * 128 + c]); sum += cur;
            const int cnt = min(t0 + tl + 1, win);
            As[tl * TP + c] = f2bf(sum / (float)cnt - cur);
            sum -= bf2f(us[(15 + tl - (win - 1)) * 128 + c]);
        }
    } else {
        for (int bb = 32 * qd; bb < 32 * qd + 32; ++bb) {
            const float u = bf2f(p.zb[((size_t)MP + bb) * DIN + 2048 + g * 128 + c]); float sum = u;
            const float* sp = p.state_pool + ((size_t)(l * SB + bb) * 15) * 512 + g * 128 + c;
            for (int r = 16 - win; r < 15; ++r) sum += sp[r * 512];
            As[bb * TP + c] = f2bf(sum / (float)win - u);
        }
    }
    __syncthreads();
    bf16x8 a[4];
#pragma unroll
    for (int s = 0; s < 4; ++s) a[s] = *(const bf16x8*)(As + (16 * w + fr) * TP + 32 * s + 8 * fq);
    bf16_t* mr = p.mixb + (rowbase + 16 * w + fr) * DM + 512 + g * 128 + 4 * fq;
    const float* ps = p.pool_scale + l * 512 + g * 128 + 4 * fq;
#pragma unroll
    for (int n = 0; n < 8; ++n) {
        f32x4 acc = (f32x4){0.f, 0.f, 0.f, 0.f};
#pragma unroll
        for (int s = 0; s < 4; ++s) acc = mfma16(*(const bf16x8*)(Bs + (16 * n + fr) * TP + 32 * s + 8 * fq), a[s], acc);
        const f32x4 sc = *(const f32x4*)(ps + 16 * n);
        u32x2 wv; wv.x = cvt_pk_bf16(acc[0] * sc[0], acc[1] * sc[1]); wv.y = cvt_pk_bf16(acc[2] * sc[2], acc[3] * sc[3]);
        *(u32x2*)(mr + 16 * n) = wv;
    }
    __syncthreads();
}

constexpr int NPHASE = 2 + 8 * NL + 1;
__global__ void __launch_bounds__(512, 2) fwd_megakernel(P parg) {
    extern __shared__ __attribute__((aligned(16))) unsigned char shm[];
    cg::grid_group grid = cg::this_grid();
    LAS unsigned char* lds = (LAS unsigned char*)shm;
    for (int ph = 0; ph < NPHASE; ++ph) {
        const P& p = parg;
        const int G = gridDim.x, bid = blockIdx.x;
        pg8::StaticOrder S;
        const int l = (ph - 2) >> 3, k = (ph < 2) ? ph : (ph == NPHASE - 1 ? 10 : 2 + ((ph - 2) & 7));
        switch (k) {
        case 0: prep_phase(p, shm); break;
        case 1: { pg8::Gemm g{p.cb, p.wt_ada, 256, MODLD, 1024}; S.init(256, MODLD, G, bid); EpiMod E{p.mod, p.b_ada}; pg8::gemm_phase(lds, g, S, E); } break;
        case 2: norm_phase(p, l, 0); break;
        case 3: { pg8::Gemm g{p.hb, p.wt_in + (size_t)l * DIN * 1024, MPAD, DIN, 1024}; S.init(MPAD, DIN, G, bid);
            EpiIn E{p.zb, p.cosT, p.sinT, p.out + O_POOLP + (size_t)l * NB * 15 * 512, p.out + O_POOLS + (size_t)l * SB * 15 * 512};
            pg8::gemm_phase(lds, g, S, E); } break;
        case 4:
            for (int it = bid; it < 1540; it += G) {
                if (it < 512) u_unit(p, it, shm);
                else if (it < 1024) sret_unit(p, l, it - 512, shm);
                else if (it < 1536) pool_unit(p, l, it - 1024, false, shm);
                else pool_unit(p, l, it - 1536, true, shm);
            }
            break;
        case 5: for (int it = bid; it < 512; it += G) o_unit(p, l, it, shm); break;
        case 6: { pg8::Gemm g{p.mixb, p.wt_out + (size_t)l * 1024 * 1024, MPAD, 1024, 1024}; S.init(MPAD, 1024, G, bid);
            EpiRes E{p.x, p.mod + l * MODW + 2 * DM}; pg8::gemm_phase(lds, g, S, E); } break;
        case 7: norm_phase(p, l, 1); break;
        case 8: { pg8::Gemm g{p.hb, p.wt_gu + (size_t)l * 2 * DFF * 1024, MPAD, 2 * DFF, 1024}; S.init(MPAD, 2 * DFF, G, bid);
            EpiGu E{p.actb}; pg8::gemm_phase(lds, g, S, E); } break;
        case 9: { pg8::Gemm g{p.actb, p.wt_down + (size_t)l * 1024 * DFF, MPAD, 1024, DFF}; S.init(MPAD, 1024, G, bid);
            EpiRes E{p.x, p.mod + l * MODW + 5 * DM}; pg8::gemm_phase(lds, g, S, E); } break;
        default: final_norm_phase(p); break;
        }
        if (ph != NPHASE - 1) grid.sync();
    }
}

extern "C" void kernel_launch(void* const* d_in, const int* in_sizes, int n_in, void* d_out, int out_size, void* d_ws, size_t ws_size, hipStream_t stream) {
    static int grid_blocks = 0;
    size_t off = 0;
    auto take = [&](size_t bytes) { size_t o = off; off += (bytes + 255) & ~(size_t)255; return o; };
    const size_t o_wt_in = take((size_t)NL * DIN * 1024 * 2), o_wt_out = take((size_t)NL * 1024 * 1024 * 2), o_wt_gu = take((size_t)NL * 2 * DFF * 1024 * 2),
                 o_wt_down = take((size_t)NL * 1024 * DFF * 2), o_wt_ada = take((size_t)NL * MODW * 1024 * 2), o_wt_pool = take((size_t)NL * 4 * 16384 * 2),
                 o_cb = take((size_t)256 * 1024 * 2), o_hb = take((size_t)MPAD * 1024 * 2), o_zb = take((size_t)MPAD * DFF * 2), o_mixb = take((size_t)MPAD * 1024 * 2),
                 o_mod = take((size_t)NCOND * MODLD * 4), o_x = take((size_t)MPAD * 1024 * 4), o_U = take((size_t)512 * 16384 * 4),
                 o_cos = take((size_t)2049 * 64 * 4), o_sin = take((size_t)2049 * 64 * 4);
    if (grid_blocks == 0) {
        if (n_in != 18 || off > ws_size) { fprintf(stderr, "kernel_launch: need 18 inputs and %zu bytes of workspace, got %d / %zu\n", off, n_in, ws_size); grid_blocks = -1; return; }
        int dev = 0, cus = 0, per_cu = 0;
        (void)hipGetDevice(&dev);
        (void)hipDeviceGetAttribute(&cus, hipDeviceAttributeMultiprocessorCount, dev);
        if (hipFuncSetAttribute((const void*)fwd_megakernel, hipFuncAttributeMaxDynamicSharedMemorySize, LDS_BYTES) != hipSuccess) { fprintf(stderr, "kernel_launch: hipFuncSetAttribute failed\n"); grid_blocks = -1; return; }
        if (hipOccupancyMaxActiveBlocksPerMultiprocessor(&per_cu, (const void*)fwd_megakernel, 512, LDS_BYTES) != hipSuccess || per_cu < 1) { fprintf(stderr, "kernel_launch: occupancy query failed (%d)\n", per_cu); grid_blocks = -1; return; }
        grid_blocks = cus * per_cu;
    }
    if (grid_blocks < 0) return;
    P p{};
    const float** pin = (const float**)&p;
    for (int i = 0; i < 18; ++i) pin[i] = (const float*)d_in[i];
    p.out = (float*)d_out;
    unsigned char* ws = (unsigned char*)d_ws;
    p.wt_in = (bf16_t*)(ws + o_wt_in); p.wt_out = (bf16_t*)(ws + o_wt_out); p.wt_gu = (bf16_t*)(ws + o_wt_gu); p.wt_down = (bf16_t*)(ws + o_wt_down);
    p.wt_ada = (bf16_t*)(ws + o_wt_ada); p.wt_pool = (bf16_t*)(ws + o_wt_pool); p.cb = (bf16_t*)(ws + o_cb); p.hb = (bf16_t*)(ws + o_hb);
    p.zb = (bf16_t*)(ws + o_zb); p.actb = (bf16_t*)(ws + o_zb); p.mixb = (bf16_t*)(ws + o_mixb);
    p.mod = (float*)(ws + o_mod); p.x = (float*)(ws + o_x); p.U = (float*)(ws + o_U); p.cosT = (float*)(ws + o_cos); p.sinT = (float*)(ws + o_sin);
    void* args[] = {&p};
    hipError_t e = hipLaunchCooperativeKernel((const void*)fwd_megakernel, dim3(grid_blocks), dim3(512), args, LDS_BYTES, stream);
    if (e != hipSuccess) fprintf(stderr, "cooperative launch failed: %s (grid %d)\n", hipGetErrorString(e), grid_blocks);
}
```

```cpp
#include <hip/hip_runtime.h>
#include <hip/hip_cooperative_groups.h>
#include <cstdio>
namespace cg = cooperative_groups;

#define LAS __attribute__((address_space(3)))
typedef unsigned short bf16_t;
typedef short bf16x8 __attribute__((ext_vector_type(8)));
typedef float f32x4 __attribute__((ext_vector_type(4)));
typedef unsigned u32x2 __attribute__((ext_vector_type(2)));
typedef unsigned u32x4 __attribute__((ext_vector_type(4)));

constexpr int DM = 1024, NB = 8, SEQ = 2048, NL = 4, SB = 128;
constexpr int MP = NB * SEQ;
constexpr int MV = MP + SB;
constexpr int MPAD = 16640;
constexpr int DIN = 2560, DFF = 2816, NCOND = 136, MODW = 6 * DM, MODLD = NL * MODW;
constexpr int LDS_BYTES = 131072 + 16;
constexpr int TP = 136;

constexpr size_t O_YP = 0, O_YS = (size_t)MP * DM, O_RETP = O_YS + (size_t)SB * DM,
                 O_POOLP = O_RETP + (size_t)NL * NB * 4 * 128 * 128, O_RETS = O_POOLP + (size_t)NL * NB * 15 * 512,
                 O_POOLS = O_RETS + (size_t)NL * SB * 4 * 128 * 128;

struct P {
    const float *x_prompt, *x_sample, *c_prompt, *c_sample, *state_ret, *state_pool, *norm_mix, *norm_ffn, *w_ada, *b_ada, *w_in, *ret_gn,
        *pool_w, *pool_scale, *w_out, *w_gu, *w_down, *final_norm;
    float* out;
    bf16_t *wt_in, *wt_out, *wt_gu, *wt_down, *wt_ada, *wt_pool, *cb, *hb, *zb, *mixb, *actb;
    float *mod, *x, *U, *cosT, *sinT;
    bf16_t* Sb; unsigned* bar;
};

__device__ __forceinline__ unsigned cvt_pk_bf16(float lo, float hi) { unsigned r; asm("v_cvt_pk_bf16_f32 %0, %1, %2" : "=v"(r) : "v"(lo), "v"(hi)); return r; }
__device__ __forceinline__ bf16_t f2bf(float f) { return (bf16_t)(cvt_pk_bf16(f, 0.f) & 0xffffu); }
__device__ __forceinline__ float bf2f(bf16_t b) { return __uint_as_float(((unsigned)b) << 16); }
__device__ __forceinline__ float bflo(unsigned u) { return __uint_as_float(u << 16); }
__device__ __forceinline__ float bfhi(unsigned u) { return __uint_as_float(u & 0xffff0000u); }
__device__ __forceinline__ float silu_f(float a) { return a * __builtin_amdgcn_rcpf(1.f + __expf(-a)); }
__device__ __forceinline__ int cond_row(int row) { return row < MP ? (row >> 11) : min(NB + row - MP, NCOND - 1); }
__device__ __forceinline__ f32x4 mfma16(bf16x8 a, bf16x8 b, f32x4 c) { return __builtin_amdgcn_mfma_f32_16x16x32_bf16(a, b, c, 0, 0, 0); }
__device__ __forceinline__ float wave_sum(float v) {
#pragma unroll
    for (int o = 32; o > 0; o >>= 1) v += __shfl_xor(v, o, 64);
    return v;
}

__device__ __forceinline__ int opaque_tid() { int t = threadIdx.x; asm volatile("" : "+v"(t)); return t; }

namespace pg8 {
constexpr int BM = 256, BK = 64, HALF = 128, HTB = HALF * BK * 2, STAGE_BYTES = 8 * HTB, NXCD = 8, WGM = 8;
__host__ __device__ __forceinline__ int lds_byte(int r, int c) { const int st = (r >> 4) * 2 + (c >> 5), rr = r & 15, cc = c & 31, ob = rr * 64 + cc * 2; return st * 1024 + (ob ^ (((ob >> 9) & 1) << 5)); }
__host__ __device__ __forceinline__ void stage_rc(int b, int& R, int& C) { const int st = b / 1024, sb = b % 1024, swz = sb ^ (((sb >> 9) & 1) << 5); R = (st >> 1) * 16 + swz / 64; C = (st & 1) * 32 + (swz % 64) / 2; }
struct Unit { int pm, pn; };
struct Gemm { const bf16_t* A; const bf16_t* Bt; int M, N, K; };
struct StaticOrder {
    int nM, nN, nwg, G, c;
    __device__ void init(int M, int N, int G_, int c_) { nM = M / BM; nN = N / BM; nwg = nM * nN; G = G_; c = c_; }
    __device__ bool next(int i, Unit& u) const {
        const long L = (long)i * G + c; if (L >= nwg) return false;
        int wgid = (int)L; { const int q = nwg / NXCD, r = nwg % NXCD, xcd = wgid % NXCD, off = wgid / NXCD; wgid = (xcd < r ? xcd * (q + 1) : r * (q + 1) + (xcd - r) * q) + off; }
        const int nig = WGM * nN, gid = wgid / nig, fm = gid * WGM, gsz = (nM - fm) < WGM ? (nM - fm) : WGM;
        u.pm = fm + ((wgid % nig) % gsz); u.pn = (wgid % nig) / gsz; return true;
    }
};

template <class Epi>
__device__ __forceinline__ void gemm_phase(LAS unsigned char* lds, const Gemm g, const StaticOrder& S, const Epi& E) {
    const int tid = opaque_tid(), wid = __builtin_amdgcn_readfirstlane(tid >> 6), lane = tid & 63, wr = wid >> 2, wc = wid & 3, fr = lane & 15, fq = lane >> 4;
    const int K = g.K, nt = K / BK;
    unsigned voffA[2];
#pragma unroll
    for (int i = 0; i < 2; ++i) { int R, C; stage_rc(tid * 16 + i * 8192, R, C); voffA[i] = (unsigned)(R * K + C) * 2u; }
    const size_t kstep = (size_t)(BK * 2);
    const size_t hstep = (size_t)HALF * K * 2;
    const size_t tstep = 2 * hstep;
    const unsigned ldsw = (unsigned)wid * 1024u;
    const int aoff = lds_byte(wr * 64 + fr, fq * 8), boff = lds_byte(wc * 32 + fr, fq * 8);
#define PG8_SA(b, h) (((b) * 2 + (h)) * HTB)
#define PG8_SB(b, h) ((4 + (b) * 2 + (h)) * HTB)
#define PG8_STAGE(bufoff, gbase) do { _Pragma("unroll") for (int _i = 0; _i < 2; ++_i) \
        __builtin_amdgcn_global_load_lds((const unsigned*)((const char*)(gbase) + voffA[_i]), (LAS unsigned*)(lds + (bufoff) + ldsw + _i * 8192), 16, 0, 0); } while (0)
#define PG8_LDA(dst, b, h) do { _Pragma("unroll") for (int m = 0; m < 4; ++m) _Pragma("unroll") for (int k = 0; k < 2; ++k) dst[m][k] = *(const LAS bf16x8*)(lds + PG8_SA(b, h) + aoff + m * 2048 + k * 1024); } while (0)
#define PG8_LDB(dst, b, h) do { _Pragma("unroll") for (int n = 0; n < 2; ++n) _Pragma("unroll") for (int k = 0; k < 2; ++k) dst[n][k] = *(const LAS bf16x8*)(lds + PG8_SB(b, h) + boff + n * 2048 + k * 1024); } while (0)
#define PG8_MMA(ai, bj, At, Bt) do { __builtin_amdgcn_s_setprio(1); _Pragma("unroll") for (int m = 0; m < 4; ++m) _Pragma("unroll") for (int n = 0; n < 2; ++n) _Pragma("unroll") for (int k = 0; k < 2; ++k) \
        acc[ai][bj][m][n] = __builtin_amdgcn_mfma_f32_16x16x32_bf16(Bt[n][k], At[m][k], acc[ai][bj][m][n], 0, 0, 0); __builtin_amdgcn_s_setprio(0); } while (0)
#define PG8_WAIT_V(n) asm volatile("s_waitcnt vmcnt(" #n ")" ::: "memory")
#define PG8_WAIT_L(n) asm volatile("s_waitcnt lgkmcnt(" #n ")" ::: "memory")
#define PG8_BAR __builtin_amdgcn_s_barrier()
#define PG8_SCHED __builtin_amdgcn_sched_barrier(0)
    Unit cur, nxt; int ui = 0;
    if (!S.next(0, cur)) return;
    f32x4 acc[2][2][4][2];
#pragma unroll
    for (int a = 0; a < 2; ++a)
#pragma unroll
        for (int b = 0; b < 2; ++b)
#pragma unroll
            for (int m = 0; m < 4; ++m)
#pragma unroll
                for (int n = 0; n < 2; ++n) acc[a][b][m][n] = (f32x4){0.f, 0.f, 0.f, 0.f};
    bf16x8 At[4][2], B0[2][2], B1[2][2];
    const char* cA = (const char*)g.A + (size_t)cur.pm * tstep; const char* cB = (const char*)g.Bt + (size_t)cur.pn * tstep;
    PG8_STAGE(PG8_SB(0, 0), cB); PG8_STAGE(PG8_SA(0, 0), cA); PG8_STAGE(PG8_SB(0, 1), cB + hstep); PG8_STAGE(PG8_SA(0, 1), cA + hstep);
    if (wr == 1) PG8_BAR;
    PG8_WAIT_V(4); PG8_BAR;
    PG8_STAGE(PG8_SB(1, 0), cB + kstep); PG8_STAGE(PG8_SA(1, 0), cA + kstep); PG8_STAGE(PG8_SB(1, 1), cB + hstep + kstep);
    PG8_WAIT_V(6); PG8_BAR;
    for (;;) {
        const bool has_next = S.next(ui + 1, nxt);
        const char* nA = has_next ? (const char*)g.A + (size_t)nxt.pm * tstep : cA; const char* nB = has_next ? (const char*)g.Bt + (size_t)nxt.pn * tstep : cB;
        for (int t = 0; t < nt; t += 2) {
            const bool last = (t == nt - 2);
            const char* a1 = cA + (size_t)(t + 1) * kstep;
            const char* a2 = last ? nA : cA + (size_t)(t + 2) * kstep; const char* b2 = last ? nB : cB + (size_t)(t + 2) * kstep;
            const char* a3 = a2 + kstep; const char* b3 = b2 + kstep;
            PG8_LDB(B0, 0, 0); PG8_SCHED; PG8_LDA(At, 0, 0); PG8_STAGE(PG8_SA(1, 1), a1 + hstep);
            PG8_WAIT_L(8); PG8_BAR; PG8_WAIT_L(0); PG8_MMA(0, 0, At, B0); PG8_BAR; PG8_SCHED;
            PG8_LDB(B1, 0, 1); PG8_STAGE(PG8_SB(0, 0), b2);
            PG8_BAR; PG8_WAIT_L(0); PG8_MMA(0, 1, At, B1); PG8_BAR;
            PG8_LDA(At, 0, 1); PG8_STAGE(PG8_SA(0, 0), a2);
            PG8_BAR; PG8_WAIT_L(0); PG8_MMA(1, 0, At, B0); PG8_BAR; PG8_SCHED;
            PG8_STAGE(PG8_SB(0, 1), b2 + hstep);
            PG8_WAIT_V(6); PG8_BAR; PG8_MMA(1, 1, At, B1); PG8_BAR;
            PG8_LDB(B0, 1, 0); PG8_SCHED; PG8_LDA(At, 1, 0); PG8_STAGE(PG8_SA(0, 1), a2 + hstep);
            PG8_WAIT_L(8); PG8_BAR; PG8_WAIT_L(0); PG8_MMA(0, 0, At, B0); PG8_BAR; PG8_SCHED;
            PG8_LDB(B1, 1, 1); PG8_STAGE(PG8_SB(1, 0), b3);
            PG8_BAR; PG8_WAIT_L(0); PG8_MMA(0, 1, At, B1); PG8_BAR;
            PG8_LDA(At, 1, 1); PG8_STAGE(PG8_SA(1, 0), a3);
            PG8_BAR; PG8_WAIT_L(0); PG8_MMA(1, 0, At, B0); PG8_BAR; PG8_SCHED;
            PG8_STAGE(PG8_SB(1, 1), b3 + hstep);
            PG8_WAIT_V(6); PG8_BAR; PG8_MMA(1, 1, At, B1); PG8_BAR;
        }
        E(acc, cur, wr, wc, fr, fq);
        if (!has_next) break;
#pragma unroll
        for (int a = 0; a < 2; ++a)
#pragma unroll
            for (int b = 0; b < 2; ++b)
#pragma unroll
                for (int m = 0; m < 4; ++m)
#pragma unroll
                    for (int n = 0; n < 2; ++n) acc[a][b][m][n] = (f32x4){0.f, 0.f, 0.f, 0.f};
        cur = nxt; cA = nA; cB = nB; ++ui;
    }
    PG8_WAIT_V(0);
    if (wr == 0) PG8_BAR;
    PG8_BAR;
#undef PG8_SA
#undef PG8_SB
#undef PG8_STAGE
#undef PG8_LDA
#undef PG8_LDB
#undef PG8_MMA
#undef PG8_WAIT_V
#undef PG8_WAIT_L
#undef PG8_BAR
#undef PG8_SCHED
}
}
using pg8::Unit;
typedef f32x4 Acc[2][2][4][2];

struct EpiMod {
    float* mod; const float* bias;
    __device__ __forceinline__ void operator()(const Acc& acc, const Unit& u, int wr, int wc, int fr, int fq) const {
        const int row0 = wr * 64 + fr, col0 = u.pn * 256 + wc * 32 + 4 * fq;
        f32x4 bv[2][2];
#pragma unroll
        for (int bj = 0; bj < 2; ++bj)
#pragma unroll
            for (int n = 0; n < 2; ++n) bv[bj][n] = *(const f32x4*)(bias + col0 + bj * 128 + n * 16);
#pragma unroll
        for (int ai = 0; ai < 2; ++ai)
#pragma unroll
            for (int m = 0; m < 4; ++m) { const int row = row0 + ai * 128 + m * 16; if (row < NCOND) {
#pragma unroll
                for (int bj = 0; bj < 2; ++bj)
#pragma unroll
                    for (int n = 0; n < 2; ++n) { const int c = col0 + bj * 128 + n * 16; *(f32x4*)(mod + (size_t)row * MODLD + c) = acc[ai][bj][m][n] + bv[bj][n]; } } }
    }
};
struct EpiIn {
    bf16_t* zb; const float* cosT; const float* sinT; float* poolp; float* pools;
    __device__ __forceinline__ void operator()(const Acc& acc, const Unit& u, int wr, int wc, int fr, int fq) const {
        const int pn = u.pn, row0 = u.pm * 256 + wr * 64 + fr;
        if (pn < 4) {
            const float sc = (pn >= 2) ? 0.08838834764831845f : 1.f;
            const int i0 = 16 * wc + 4 * fq;
            f32x4 cs[2][4], sn[2][4];
#pragma unroll
            for (int ai = 0; ai < 2; ++ai)
#pragma unroll
                for (int m = 0; m < 4; ++m) {
                    const int row = row0 + ai * 128 + m * 16; const int pi = row < MP ? (row & 2047) : 2048;
                    cs[ai][m] = *(const f32x4*)(cosT + pi * 64 + i0); sn[ai][m] = *(const f32x4*)(sinT + pi * 64 + i0);
                }
#pragma unroll
            for (int ai = 0; ai < 2; ++ai)
#pragma unroll
                for (int m = 0; m < 4; ++m) {
                    const int row = row0 + ai * 128 + m * 16;
                    const f32x4 c4 = cs[ai][m] * sc, s4 = sn[ai][m] * sc;
#pragma unroll
                    for (int bj = 0; bj < 2; ++bj) {
                        const f32x4 x1 = acc[ai][bj][m][0], x2 = acc[ai][bj][m][1];
                        const f32x4 o1 = x1 * c4 - x2 * s4, o2 = x1 * s4 + x2 * c4;
                        bf16_t* dst = zb + (size_t)row * DIN + pn * 256 + bj * 128 + i0;
                        u32x2 w1, w2; w1.x = cvt_pk_bf16(o1[0], o1[1]); w1.y = cvt_pk_bf16(o1[2], o1[3]); w2.x = cvt_pk_bf16(o2[0], o2[1]); w2.y = cvt_pk_bf16(o2[2], o2[3]);
                        *(u32x2*)dst = w1; *(u32x2*)(dst + 64) = w2;
                    }
                }
        } else {
#pragma unroll
            for (int ai = 0; ai < 2; ++ai)
#pragma unroll
                for (int m = 0; m < 4; ++m) {
                    const int row = row0 + ai * 128 + m * 16;
#pragma unroll
                    for (int bj = 0; bj < 2; ++bj) {
                        const f32x4 v0 = acc[ai][bj][m][0], v1 = acc[ai][bj][m][1];
                        const int col = pn * 256 + bj * 128 + wc * 32 + 8 * fq;
                        u32x4 w; w.x = cvt_pk_bf16(v0[0], v0[1]); w.y = cvt_pk_bf16(v0[2], v0[3]); w.z = cvt_pk_bf16(v1[0], v1[1]); w.w = cvt_pk_bf16(v1[2], v1[3]);
                        *(u32x4*)(zb + (size_t)row * DIN + col) = w;
                        if (pn >= 8) {
                            float* dst = nullptr;
                            if (row < MP) { const int t = row & 2047; if (t >= SEQ - 15) dst = poolp + ((size_t)((row >> 11) * 15 + (t - (SEQ - 15)))) * 512 + (col - 2048); }
                            else if (row < MV) dst = pools + ((size_t)((row - MP) * 15 + 14)) * 512 + (col - 2048);
                            if (dst) { *(f32x4*)dst = v0; *(f32x4*)(dst + 4) = v1; }
                        }
                    }
                }
        }
    }
};
struct EpiRes {
    float* x; const float* gate; float scale;
    __device__ __forceinline__ void operator()(const Acc& acc, const Unit& u, int wr, int wc, int fr, int fq) const {
        const int row0 = u.pm * 256 + wr * 64 + fr, col0 = u.pn * 256 + wc * 32 + 4 * fq;
        if (u.pm < MP / 256) {
            const float* gr = gate + (size_t)(u.pm >> 3) * MODLD + col0;
            f32x4 gv[2][2];
#pragma unroll
            for (int bj = 0; bj < 2; ++bj)
#pragma unroll
                for (int n = 0; n < 2; ++n) gv[bj][n] = *(const f32x4*)(gr + bj * 128 + n * 16) * scale;
#pragma unroll
            for (int ai = 0; ai < 2; ++ai) {
                f32x4 xv[4][2][2];
#pragma unroll
                for (int m = 0; m < 4; ++m)
#pragma unroll
                    for (int bj = 0; bj < 2; ++bj)
#pragma unroll
                        for (int n = 0; n < 2; ++n) xv[m][bj][n] = *(const f32x4*)(x + (size_t)(row0 + ai * 128 + m * 16) * DM + col0 + bj * 128 + n * 16);
#pragma unroll
                for (int m = 0; m < 4; ++m)
#pragma unroll
                    for (int bj = 0; bj < 2; ++bj)
#pragma unroll
                        for (int n = 0; n < 2; ++n) *(f32x4*)(x + (size_t)(row0 + ai * 128 + m * 16) * DM + col0 + bj * 128 + n * 16) = xv[m][bj][n] + gv[bj][n] * acc[ai][bj][m][n];
            }
        } else {
#pragma unroll
            for (int ai = 0; ai < 2; ++ai)
#pragma unroll
                for (int mh = 0; mh < 2; ++mh) {
                    f32x4 xv[2][2][2], gv[2][2][2];
#pragma unroll
                    for (int ml = 0; ml < 2; ++ml) {
                        const int row = row0 + ai * 128 + (mh * 2 + ml) * 16; const float* gr = gate + (size_t)cond_row(row) * MODLD + col0; const float* xr = x + (size_t)row * DM + col0;
#pragma unroll
                        for (int bj = 0; bj < 2; ++bj)
#pragma unroll
                            for (int n = 0; n < 2; ++n) { xv[ml][bj][n] = *(const f32x4*)(xr + bj * 128 + n * 16); gv[ml][bj][n] = *(const f32x4*)(gr + bj * 128 + n * 16); }
                    }
#pragma unroll
                    for (int ml = 0; ml < 2; ++ml) {
                        const int row = row0 + ai * 128 + (mh * 2 + ml) * 16; float* xr = x + (size_t)row * DM + col0;
#pragma unroll
                        for (int bj = 0; bj < 2; ++bj)
#pragma unroll
                            for (int n = 0; n < 2; ++n) *(f32x4*)(xr + bj * 128 + n * 16) = xv[ml][bj][n] + gv[ml][bj][n] * scale * acc[ai][bj][m_of(mh, ml)][n];
                    }
                }
        }
    }
    static __device__ __forceinline__ constexpr int m_of(int mh, int ml) { return mh * 2 + ml; }
};
struct EpiGu {
    bf16_t* act;
    __device__ __forceinline__ void operator()(const Acc& acc, const Unit& u, int wr, int wc, int fr, int fq) const {
        const int row0 = u.pm * 256 + wr * 64 + fr, col = u.pn * 128 + wc * 32 + 8 * fq;
#pragma unroll
        for (int ai = 0; ai < 2; ++ai)
#pragma unroll
            for (int m = 0; m < 4; ++m) {
                const int row = row0 + ai * 128 + m * 16;
                float r[8];
#pragma unroll
                for (int n = 0; n < 2; ++n)
#pragma unroll
                    for (int j = 0; j < 4; ++j) r[n * 4 + j] = silu_f(acc[ai][0][m][n][j]) * acc[ai][1][m][n][j];
                u32x4 w; w.x = cvt_pk_bf16(r[0], r[1]); w.y = cvt_pk_bf16(r[2], r[3]); w.z = cvt_pk_bf16(r[4], r[5]); w.w = cvt_pk_bf16(r[6], r[7]);
                *(u32x4*)(act + (size_t)row * DFF + col) = w;
            }
    }
};

__device__ __forceinline__ int orig_col(int mode, int np) {
    if (mode == 0) return np;
    const int perm8 = (np & ~31) + 8 * ((np >> 2) & 3) + 4 * ((np >> 4) & 1) + (np & 3);
    if (mode == 1) return perm8;
    if (mode == 2) {
        if (np >= 1024) return perm8;
        const int c = np & 127; return (np & ~127) + 64 * ((c >> 4) & 1) + 16 * (c >> 5) + (c & 15);
    }
    const int pn = np >> 8, c = np & 255, bj = c >> 7, wc = (c >> 5) & 3, n = (c >> 4) & 1, fq = (c >> 2) & 3, j = c & 3;
    return bj * DFF + pn * 128 + 32 * wc + 8 * fq + 4 * n + j;
}
__device__ void prep_phase(const P& p, unsigned char* shm) {
    float(*tile)[65] = (float(*)[65])shm;
    const int tid = opaque_tid();
    constexpr int T_IN = 40 * 8, T_OUT = 16 * 8, T_GU = 88 * 8, T_DN = 16 * 22, T_ADA = 96 * 8, T_POOL = 2;
    constexpr int TOT = NL * (T_IN + T_OUT + T_GU + T_DN + T_ADA) + 16 * T_POOL;
    struct Job { const float* src; bf16_t* dst; int K, N, oc, k0, n0; };
    auto job = [&](int it) {
        int r = it, tl, K, N, mode; const float* src; bf16_t* dst;
        if (r < NL * T_IN) { const int l = r / T_IN; tl = r % T_IN; K = 1024; N = DIN; mode = 2; src = p.w_in + (size_t)l * K * N; dst = p.wt_in + (size_t)l * K * N; }
        else if ((r -= NL * T_IN) < NL * T_OUT) { const int l = r / T_OUT; tl = r % T_OUT; K = 1024; N = 1024; mode = 0; src = p.w_out + (size_t)l * K * N; dst = p.wt_out + (size_t)l * K * N; }
        else if ((r -= NL * T_OUT) < NL * T_GU) { const int l = r / T_GU; tl = r % T_GU; K = 1024; N = 2 * DFF; mode = 3; src = p.w_gu + (size_t)l * K * N; dst = p.wt_gu + (size_t)l * K * N; }
        else if ((r -= NL * T_GU) < NL * T_DN) { const int l = r / T_DN; tl = r % T_DN; K = DFF; N = 1024; mode = 0; src = p.w_down + (size_t)l * K * N; dst = p.wt_down + (size_t)l * K * N; }
        else if ((r -= NL * T_DN) < NL * T_ADA) { const int l = r / T_ADA; tl = r % T_ADA; K = 1024; N = MODW; mode = 0; src = p.w_ada + (size_t)l * K * N; dst = p.wt_ada + (size_t)l * K * N; }
        else { r -= NL * T_ADA; const int mtx = r / T_POOL; tl = r % T_POOL; K = 128; N = 128; mode = 0; src = p.pool_w + (size_t)mtx * 16384; dst = p.wt_pool + (size_t)mtx * 16384; }
        const int nkt = K / 128, ntile = tl / nkt, kt = tl % nkt;
        Job j; j.src = src; j.dst = dst; j.K = K; j.N = N; j.k0 = kt * 128; j.n0 = ntile * 64; j.oc = orig_col(mode, ntile * 64 + (tid & 63));
        return j;
    };
    float rg[16];
    int it = blockIdx.x;
    Job cj = {};
    if (it < TOT) { cj = job(it);
#pragma unroll
        for (int i = 0; i < 16; ++i) rg[i] = cj.src[(size_t)(cj.k0 + i * 8 + (tid >> 6)) * cj.N + cj.oc]; }
    while (it < TOT) {
#pragma unroll
        for (int i = 0; i < 16; ++i) tile[i * 8 + (tid >> 6)][tid & 63] = rg[i];
        __syncthreads();
        const Job oj = cj; it += gridDim.x;
        if (it < TOT) { cj = job(it);
#pragma unroll
            for (int i = 0; i < 16; ++i) rg[i] = cj.src[(size_t)(cj.k0 + i * 8 + (tid >> 6)) * cj.N + cj.oc]; }
        { const int k4 = (tid & 31) * 4;
#pragma unroll
          for (int i = 0; i < 4; ++i) { const int nn = i * 16 + (tid >> 5);
              u32x2 wv; wv.x = cvt_pk_bf16(tile[k4][nn], tile[k4 + 1][nn]); wv.y = cvt_pk_bf16(tile[k4 + 2][nn], tile[k4 + 3][nn]);
              *(u32x2*)(oj.dst + (size_t)(oj.n0 + nn) * oj.K + oj.k0 + k4) = wv; } }
        __syncthreads();
    }
    const size_t gtid = (size_t)blockIdx.x * 512 + tid, gsz = (size_t)gridDim.x * 512;
    for (size_t i = gtid; i < (size_t)MPAD * 256; i += gsz) {
        const size_t row = i >> 8; f32x4 v = (f32x4){0.f, 0.f, 0.f, 0.f};
        if (row < MP) v = ((const f32x4*)p.x_prompt)[i]; else if (row < MV) v = ((const f32x4*)p.x_sample)[i - (size_t)MP * 256];
        ((f32x4*)p.x)[i] = v;
    }
    for (size_t i = gtid; i < (size_t)256 * 512; i += gsz) {
        const int row = (int)(i >> 9), c2 = (int)(i & 511) * 2; float a = 0.f, b = 0.f;
        if (row < NB) { a = p.c_prompt[row * DM + c2]; b = p.c_prompt[row * DM + c2 + 1]; }
        else if (row < NCOND) { a = p.c_sample[(row - NB) * DM + c2]; b = p.c_sample[(row - NB) * DM + c2 + 1]; }
        *(unsigned*)(p.cb + (size_t)row * DM + c2) = cvt_pk_bf16(silu_f(a), silu_f(b));
    }
    for (size_t i = gtid; i < (size_t)2049 * 64; i += gsz) {
        const int pi = (int)(i >> 6), k = (int)(i & 63); const float pos = pi < 2048 ? (float)pi : 16384.f;
        const float inv = 1.0f / exp2f((float)k * (13.287712379549449f / 64.f));
        const float angf = pos * inv; const double a = (double)angf;
        const double kq = rint(a * 0.63661977236758134308);
        double y = fma(-kq, 1.57079632679489655800e+00, a); y = fma(-kq, 6.12323399573676603587e-17, y);
        const double y2 = y * y;
        const double sy = y * (1.0 + y2 * (-1.0 / 6 + y2 * (1.0 / 120 + y2 * (-1.0 / 5040 + y2 * (1.0 / 362880 + y2 * (-1.0 / 39916800 + y2 * (1.0 / 6227020800.0)))))));
        const double cy = 1.0 + y2 * (-0.5 + y2 * (1.0 / 24 + y2 * (-1.0 / 720 + y2 * (1.0 / 40320 + y2 * (-1.0 / 3628800 + y2 * (1.0 / 479001600.0))))));
        const int q = ((int)((long long)kq)) & 3;
        const double s = (q == 0) ? sy : (q == 1) ? cy : (q == 2) ? -sy : -cy;
        const double c = (q == 0) ? cy : (q == 1) ? -sy : (q == 2) ? -cy : sy;
        p.cosT[i] = (float)c; p.sinT[i] = (float)s;
    }
    for (size_t i = gtid; i < (size_t)NL * SB * 14 * 128; i += gsz) {
        const size_t c4 = i & 127, r = (i >> 7) % 14, lb = (i >> 7) / 14;
        ((f32x4*)(p.out + O_POOLS))[(lb * 15 + r) * 128 + c4] = ((const f32x4*)p.state_pool)[(lb * 15 + r + 1) * 128 + c4];
    }
}

__device__ void norm_phase(const P& p, int l, int which) {
    const float* g = (which ? p.norm_ffn : p.norm_mix) + l * DM;
    const int shift_off = l * MODW + (which ? 3 * DM : 0), scale_off = shift_off + DM;
    const int tid_ = opaque_tid(); const int wave = tid_ >> 6, lane = tid_ & 63;
    for (int row = blockIdx.x * 8 + wave; row < MPAD; row += gridDim.x * 8) {
        const f32x4* xr = (const f32x4*)(p.x + (size_t)row * DM);
        f32x4 v[4]; float ss = 0.f;
#pragma unroll
        for (int i = 0; i < 4; ++i) { v[i] = xr[lane + 64 * i]; ss += v[i][0] * v[i][0] + v[i][1] * v[i][1] + v[i][2] * v[i][2] + v[i][3] * v[i][3]; }
        ss = wave_sum(ss);
        const float rstd = rsqrtf(ss * (1.f / DM) + 1e-6f);
        const float* mr = p.mod + (size_t)cond_row(row) * MODLD;
#pragma unroll
        for (int i = 0; i < 4; ++i) {
            const int col = 4 * (lane + 64 * i);
            const f32x4 gg = *(const f32x4*)(g + col), sc = *(const f32x4*)(mr + scale_off + col), sh = *(const f32x4*)(mr + shift_off + col);
            const f32x4 h = v[i] * rstd * gg * (sc + 1.f) + sh;
            u32x2 w; w.x = cvt_pk_bf16(h[0], h[1]); w.y = cvt_pk_bf16(h[2], h[3]);
            *(u32x2*)(p.hb + (size_t)row * DM + col) = w;
        }
    }
}
__device__ void final_norm_phase(const P& p) {
    const int tid_ = opaque_tid(); const int wave = tid_ >> 6, lane = tid_ & 63;
    for (int row = blockIdx.x * 8 + wave; row < MV; row += gridDim.x * 8) {
        const f32x4* xr = (const f32x4*)(p.x + (size_t)row * DM);
        f32x4 v[4]; float ss = 0.f;
#pragma unroll
        for (int i = 0; i < 4; ++i) { v[i] = xr[lane + 64 * i]; ss += v[i][0] * v[i][0] + v[i][1] * v[i][1] + v[i][2] * v[i][2] + v[i][3] * v[i][3]; }
        ss = wave_sum(ss);
        const float rstd = rsqrtf(ss * (1.f / DM) + 1e-6f);
        float* o = p.out + (size_t)row * DM;
#pragma unroll
        for (int i = 0; i < 4; ++i) { const int col = 4 * (lane + 64 * i); *(f32x4*)(o + col) = v[i] * rstd * *(const f32x4*)(p.final_norm + col); }
    }
}

__device__ __forceinline__ float log2_gamma(int h) { return log2f(1.f - exp2f(-5.f - (float)h)); }

__device__ void u_unit(const P& p, int unit, unsigned char* shm) {
    const int b = unit >> 6, h = (unit >> 4) & 3, c = unit & 15;
    bf16_t* VT = (bf16_t*)shm; bf16_t* KT = VT + 128 * TP;
    const int tid = opaque_tid(), w = tid >> 6, lane = tid & 63, fr = lane & 15, fq = lane >> 4;
    const float lg = log2_gamma(h);
    const size_t rowbase = (size_t)b * SEQ + c * 128;
    {
        const int t = (w & 1) * 64 + lane; const float dk = exp2f((float)(127 - t) * lg);
        const bf16_t* zr = p.zb + (rowbase + t) * DIN + h * 128;
#pragma unroll
        for (int i = 0; i < 4; ++i) {
            const int d0 = (w >> 1) * 32 + 8 * i;
            const u32x4 kk = *(const u32x4*)(zr + 512 + d0), vv = *(const u32x4*)(zr + 1024 + d0);
#pragma unroll
            for (int j = 0; j < 4; ++j) {
                KT[(d0 + 2 * j) * TP + t] = (bf16_t)(kk[j] & 0xffffu); KT[(d0 + 2 * j + 1) * TP + t] = (bf16_t)(kk[j] >> 16);
                VT[(d0 + 2 * j) * TP + t] = f2bf(bflo(vv[j]) * dk); VT[(d0 + 2 * j + 1) * TP + t] = f2bf(bfhi(vv[j]) * dk);
            }
        }
    }
    __syncthreads();
    bf16x8 a[4];
#pragma unroll
    for (int s = 0; s < 4; ++s) a[s] = *(const bf16x8*)(VT + (16 * w + fr) * TP + 32 * s + 8 * fq);
    float* Ud = p.U + (size_t)unit * 16384 + (16 * w + fr) * 128;
#pragma unroll
    for (int n = 0; n < 8; ++n) {
        f32x4 acc = (f32x4){0.f, 0.f, 0.f, 0.f};
#pragma unroll
        for (int s = 0; s < 4; ++s) acc = mfma16(*(const bf16x8*)(KT + (16 * n + fr) * TP + 32 * s + 8 * fq), a[s], acc);
        *(f32x4*)(Ud + 16 * n + 4 * fq) = acc;
    }
    __syncthreads();
}


__device__ void scan_phase(const P& p, int l) {
    const int tid = opaque_tid();
    for (int idx = blockIdx.x * 512 + tid; idx < 32 * 4096; idx += gridDim.x * 512) {
        const int bh = idx >> 12, f = idx & 4095, h = bh & 3, e = f >> 5, d0 = (f & 31) * 4;
        const float gC = exp2f(128.f * log2_gamma(h));
        const f32x4* Ub = (const f32x4*)(p.U + (size_t)bh * 16 * 16384) + f;
        u32x2* Sd = (u32x2*)(p.Sb + (size_t)bh * 16 * 16384) + f;
        f32x4 u[16];
#pragma unroll
        for (int c = 0; c < 16; ++c) u[c] = Ub[(size_t)c * 4096];
        f32x4 s = (f32x4){0.f, 0.f, 0.f, 0.f};
#pragma unroll
        for (int c = 0; c < 16; ++c) {
            u32x2 wv; wv.x = cvt_pk_bf16(s[0], s[1]); wv.y = cvt_pk_bf16(s[2], s[3]);
            Sd[(size_t)c * 4096] = wv;
            s = s * gC + u[c];
        }
        float* dst = p.out + O_RETP + ((size_t)l * 32 + bh) * 16384;
#pragma unroll
        for (int jj = 0; jj < 4; ++jj) dst[(d0 + jj) * 128 + e] = s[jj];
    }
}

__device__ void o_unit(const P& p, int l, int unit, unsigned char* shm) {
    const int b = unit >> 6, h = (unit >> 4) & 3, c = unit & 15;
    bf16_t* Ks = (bf16_t*)shm; bf16_t* VT = Ks + 128 * TP; bf16_t* ST = VT + 128 * TP;
    const int tid = opaque_tid(), w = tid >> 6, lane = tid & 63, fr = lane & 15, fq = lane >> 4;
    const float lg = log2_gamma(h);
    const size_t rowbase = (size_t)b * SEQ + c * 128;
#pragma unroll
    for (int i = 0; i < 4; ++i) {
        const int q = tid + 512 * i, row = q >> 4, ch = q & 15;
        *(u32x4*)(Ks + row * TP + ch * 8) = *(const u32x4*)(p.zb + (rowbase + row) * DIN + 512 + h * 128 + ch * 8);
    }
    {
        const int t = (w & 1) * 64 + lane; const bf16_t* zr = p.zb + (rowbase + t) * DIN + 1024 + h * 128;
#pragma unroll
        for (int i = 0; i < 4; ++i) {
            const int e0 = (w >> 1) * 32 + 8 * i; const u32x4 vv = *(const u32x4*)(zr + e0);
#pragma unroll
            for (int j = 0; j < 4; ++j) { VT[(e0 + 2 * j) * TP + t] = (bf16_t)(vv[j] & 0xffffu); VT[(e0 + 2 * j + 1) * TP + t] = (bf16_t)(vv[j] >> 16); }
        }
    }
#pragma unroll
    for (int i = 0; i < 4; ++i) {
        const int q = tid + 512 * i, row = q >> 4, ch = q & 15;
        *(u32x4*)(ST + row * TP + ch * 8) = *(const u32x4*)(p.Sb + (size_t)unit * 16384 + row * 128 + ch * 8);
    }
    __syncthreads();
    const int il = 16 * w + fr;
    bf16x8 aq[4];
    { const bf16_t* qr = p.zb + (rowbase + il) * DIN + h * 128 + 8 * fq;
#pragma unroll
      for (int s = 0; s < 4; ++s) aq[s] = *(const bf16x8*)(qr + 32 * s); }
    bf16x8 pf[4];
#pragma unroll
    for (int sp = 0; sp < 4; ++sp) {
        f32x4 a0 = (f32x4){0.f, 0.f, 0.f, 0.f}, a1 = a0;
#pragma unroll
        for (int s = 0; s < 4; ++s) {
            a0 = mfma16(*(const bf16x8*)(Ks + (32 * sp + fr) * TP + 32 * s + 8 * fq), aq[s], a0);
            a1 = mfma16(*(const bf16x8*)(Ks + (32 * sp + 16 + fr) * TP + 32 * s + 8 * fq), aq[s], a1);
        }
        float v0[4], v1[4];
#pragma unroll
        for (int jj = 0; jj < 4; ++jj) {
            const int d0 = il - (32 * sp + 4 * fq + jj), d1 = d0 - 16;
            v0[jj] = d0 >= 0 ? a0[jj] * exp2f((float)d0 * lg) : 0.f;
            v1[jj] = d1 >= 0 ? a1[jj] * exp2f((float)d1 * lg) : 0.f;
        }
        u32x4 pk; pk.x = cvt_pk_bf16(v0[0], v0[1]); pk.y = cvt_pk_bf16(v0[2], v0[3]); pk.z = cvt_pk_bf16(v1[0], v1[1]); pk.w = cvt_pk_bf16(v1[2], v1[3]);
        pf[sp] = __builtin_bit_cast(bf16x8, pk);
    }
    const float dq = exp2f((float)(il + 1) * lg);
    f32x4 o[8]; float ss = 0.f;
#pragma unroll
    for (int ne = 0; ne < 8; ++ne) {
        f32x4 ai = (f32x4){0.f, 0.f, 0.f, 0.f}, ac = ai;
        const bf16_t* vr = VT + (16 * ne + fr) * TP + 4 * fq; const bf16_t* sr = ST + (16 * ne + fr) * TP + 8 * fq;
#pragma unroll
        for (int s = 0; s < 4; ++s) {
            const u32x2 lo = *(const u32x2*)(vr + 32 * s), hi = *(const u32x2*)(vr + 32 * s + 16);
            u32x4 bv; bv.x = lo.x; bv.y = lo.y; bv.z = hi.x; bv.w = hi.y;
            ai = mfma16(__builtin_bit_cast(bf16x8, bv), pf[s], ai);
            ac = mfma16(*(const bf16x8*)(sr + 32 * s), aq[s], ac);
        }
        o[ne] = ai + ac * dq;
        ss += o[ne][0] * o[ne][0] + o[ne][1] * o[ne][1] + o[ne][2] * o[ne][2] + o[ne][3] * o[ne][3];
    }
    ss += __shfl_xor(ss, 16, 64); ss += __shfl_xor(ss, 32, 64);
    const float rstd = rsqrtf(ss * (1.f / 128.f) + 1e-6f);
    const bf16_t* gr = p.zb + (rowbase + il) * DIN + 1536 + h * 128 + 4 * fq;
    bf16_t* mr = p.mixb + (rowbase + il) * DM + h * 128 + 4 * fq;
    const float* gn = p.ret_gn + l * 512 + h * 128 + 4 * fq;
#pragma unroll
    for (int ne = 0; ne < 8; ++ne) {
        const u32x2 gg = *(const u32x2*)(gr + 16 * ne); const f32x4 g4 = *(const f32x4*)(gn + 16 * ne);
        const float r0 = o[ne][0] * rstd * g4[0] * silu_f(bflo(gg.x)), r1 = o[ne][1] * rstd * g4[1] * silu_f(bfhi(gg.x)),
                    r2 = o[ne][2] * rstd * g4[2] * silu_f(bflo(gg.y)), r3 = o[ne][3] * rstd * g4[3] * silu_f(bfhi(gg.y));
        u32x2 wv; wv.x = cvt_pk_bf16(r0, r1); wv.y = cvt_pk_bf16(r2, r3);
        *(u32x2*)(mr + 16 * ne) = wv;
    }
    __syncthreads();
}

__device__ void sret_unit(const P& p, int l, int unit, unsigned char* shm) {
    const int b = unit >> 2, h = unit & 3, tid = opaque_tid();
    float* red = (float*)shm; float* qs = red + 16 * 128; float* ks = qs + 128; float* vs = ks + 128; float* red2 = vs + 128;
    const float gam = 1.f - exp2f(-5.f - (float)h);
    const size_t row = (size_t)MP + b; const bf16_t* zr = p.zb + row * DIN + h * 128;
    if (tid < 128) { qs[tid] = bf2f(zr[tid]); ks[tid] = bf2f(zr[512 + tid]); vs[tid] = bf2f(zr[1024 + tid]); }
    __syncthreads();
    const int e0 = (tid & 31) * 4, dg = tid >> 5;
    const size_t so = ((size_t)(l * SB + b) * 4 + h) * 16384;
    const float* S0 = p.state_ret + so; float* Sn = p.out + O_RETS + so;
    const f32x4 v4 = *(const f32x4*)(vs + e0); f32x4 po = (f32x4){0.f, 0.f, 0.f, 0.f};
#pragma unroll
    for (int i = 0; i < 8; ++i) {
        const int d = dg + 16 * i; const f32x4 s = *(const f32x4*)(S0 + d * 128 + e0);
        po += s * qs[d]; *(f32x4*)(Sn + d * 128 + e0) = s * gam + v4 * ks[d];
    }
    *(f32x4*)(red + dg * 128 + e0) = po;
    __syncthreads();
    float o = 0.f;
    if (tid < 128) {
        float sum = 0.f;
#pragma unroll
        for (int g = 0; g < 16; ++g) sum += red[g * 128 + tid];
        const int ln = tid & 63;
        const float qk = wave_sum(qs[ln] * ks[ln] + qs[ln + 64] * ks[ln + 64]);
        o = qk * vs[tid] + gam * sum;
        const float ssw = wave_sum(o * o);
        if ((tid & 63) == 0) red2[tid >> 6] = ssw;
    }
    __syncthreads();
    if (tid < 128) {
        const float rstd = rsqrtf((red2[0] + red2[1]) * (1.f / 128.f) + 1e-6f);
        const float g = bf2f(zr[1536 + tid]);
        p.mixb[row * DM + h * 128 + tid] = f2bf(o * rstd * p.ret_gn[l * 512 + h * 128 + tid] * silu_f(g));
    }
    __syncthreads();
}

__device__ void pool_unit(const P& p, int l, int unit, bool sample, unsigned char* shm) {
    bf16_t* us = (bf16_t*)shm; bf16_t* As = us + 143 * 128; bf16_t* Bs = As + 128 * TP;
    const int tid = opaque_tid(), w = tid >> 6, lane = tid & 63, fr = lane & 15, fq = lane >> 4;
    int g, b = 0, t0 = 0; size_t rowbase;
    if (sample) { g = unit; rowbase = MP; } else { g = unit & 3; const int tt = (unit >> 2) & 15; b = unit >> 6; t0 = tt * 128; rowbase = (size_t)b * SEQ + t0; }
    const int win = 2 << g;
    {
        const bf16_t* wsrc = p.wt_pool + (size_t)(l * 4 + g) * 16384;
#pragma unroll
        for (int i = 0; i < 4; ++i) { const int q = tid + 512 * i, row = q >> 4, ch = q & 15; *(u32x4*)(Bs + row * TP + ch * 8) = *(const u32x4*)(wsrc + row * 128 + ch * 8); }
    }
    const int c = tid & 127, qd = tid >> 7;
    if (!sample) {
        for (int q = tid; q < 143 * 16; q += 512) {
            const int r = q >> 4, ch = q & 15, t = t0 - 15 + r; u32x4 v = (u32x4){0u, 0u, 0u, 0u};
            if (t >= 0) v = *(const u32x4*)(p.zb + ((size_t)b * SEQ + t) * DIN + 2048 + g * 128 + ch * 8);
            *(u32x4*)(us + r * 128 + ch * 8) = v;
        }
        __syncthreads();
        float sum = 0.f;
        for (int i = 1; i < win; ++i) sum += bf2f(us[(15 + 32 * qd - i) * 128 + c]);
        for (int tl = 32 * qd; tl < 32 * qd + 32; ++tl) {
            const float cur = bf2f(us[(15 + tl) * 128 + c]); sum += cur;
            const int cnt = min(t0 + tl + 1, win);
            As[tl * TP + c] = f2bf(sum / (float)cnt - cur);
            sum -= bf2f(us[(15 + tl - (win - 1)) * 128 + c]);
        }
    } else {
        for (int bb = 32 * qd; bb < 32 * qd + 32; ++bb) {
            const float u = bf2f(p.zb[((size_t)MP + bb) * DIN + 2048 + g * 128 + c]); float sum = u;
            const float* sp = p.state_pool + ((size_t)(l * SB + bb) * 15) * 512 + g * 128 + c;
            for (int r = 16 - win; r < 15; ++r) sum += sp[r * 512];
            As[bb * TP + c] = f2bf(sum / (float)win - u);
        }
    }
    __syncthreads();
    bf16x8 a[4];
#pragma unroll
    for (int s = 0; s < 4; ++s) a[s] = *(const bf16x8*)(As + (16 * w + fr) * TP + 32 * s + 8 * fq);
    bf16_t* mr = p.mixb + (rowbase + 16 * w + fr) * DM + 512 + g * 128 + 4 * fq;
    const float* ps = p.pool_scale + l * 512 + g * 128 + 4 * fq;
#pragma unroll
    for (int n = 0; n < 8; ++n) {
        f32x4 acc = (f32x4){0.f, 0.f, 0.f, 0.f};
#pragma unroll
        for (int s = 0; s < 4; ++s) acc = mfma16(*(const bf16x8*)(Bs + (16 * n + fr) * TP + 32 * s + 8 * fq), a[s], acc);
        const f32x4 sc = *(const f32x4*)(ps + 16 * n);
        u32x2 wv; wv.x = cvt_pk_bf16(acc[0] * sc[0], acc[1] * sc[1]); wv.y = cvt_pk_bf16(acc[2] * sc[2], acc[3] * sc[3]);
        *(u32x2*)(mr + 16 * n) = wv;
    }
    __syncthreads();
}


#define XB_TMO      128
#define XB_XCNT(j)  (256  + 64 * (j))
#define XB_XSUB(j)  (1280 + 64 * (j))
#define XB_XGEN(j)  (2304 + 64 * (j))
#define XB_TOP      3328
#define XB_TOPGEN   3392
#define XCD_BAR_WORDS 3456
#define XB_SPIN_CAP (1u << 18)
__device__ __forceinline__ unsigned xb_ld(unsigned* p)              { return __hip_atomic_load(p, __ATOMIC_RELAXED, __HIP_MEMORY_SCOPE_AGENT); }
__device__ __forceinline__ unsigned xb_add(unsigned* p, unsigned v) { return __hip_atomic_fetch_add(p, v, __ATOMIC_RELAXED, __HIP_MEMORY_SCOPE_AGENT); }
__device__ __forceinline__ unsigned xb_xcc_id() { return (unsigned)__builtin_amdgcn_s_getreg((3 << 11) | 20) & 0xFu; }
#define XB_SPIN(cond, bar) do { unsigned _sp = 0; while (cond) { __builtin_amdgcn_s_sleep(1); \
    if ((++_sp & 255u) == 0u) { if (xb_ld(&(bar)[XB_TMO])) break; if (_sp > XB_SPIN_CAP) { atomicAdd(&(bar)[XB_TMO], 1u); break; } } } } while (0)
struct XcdBarrier { unsigned* bar; unsigned x; volatile LAS unsigned* st; };
__device__ __forceinline__ XcdBarrier xcd_barrier_post(unsigned* bar, volatile LAS unsigned* st) {
    XcdBarrier b; b.bar = bar; b.x = xb_xcc_id(); b.st = st;
    if (threadIdx.x == 0) (void)xb_add(&bar[XB_XCNT(b.x)], 1u);
    return b;
}
__device__ __forceinline__ void xcd_barrier_complete(unsigned* bar, unsigned x, unsigned& nloc, unsigned& nx) {
    const unsigned G = gridDim.x * gridDim.y * gridDim.z;
    unsigned sum, cnt, mine, sp = 0u;
    for (;;) {
        sum = 0u; cnt = 0u; mine = 0u;
#pragma unroll
        for (unsigned j = 0; j < 16; ++j) { const unsigned c = xb_ld(&bar[XB_XCNT(j)]); sum += c; cnt += (c > 0u) ? 1u : 0u; mine = (j == x) ? c : mine; }
        if (sum == G) break;
        __builtin_amdgcn_s_sleep(1);
        if ((++sp & 255u) == 0u) { if (xb_ld(&bar[XB_TMO])) break; if (sp > XB_SPIN_CAP) { atomicAdd(&bar[XB_TMO], 1u); break; } }
    }
    nloc = mine > 0u ? mine : 1u; nx = cnt > 0u ? cnt : 1u;
}
__device__ __forceinline__ void xcd_barrier(const XcdBarrier& b) {
    asm volatile("s_waitcnt vmcnt(0)" ::: "memory");
    __syncthreads();
    if (threadIdx.x == 0) {
        unsigned* bar = b.bar;
        __builtin_amdgcn_s_waitcnt(0);
        unsigned nloc = b.st[0], nx = b.st[1];
        if (nloc == 0u) { xcd_barrier_complete(bar, b.x, nloc, nx); b.st[0] = nloc; b.st[1] = nx; }
        const unsigned old = xb_add(&bar[XB_XSUB(b.x)], 1u);
        const unsigned gen = old / nloc;
        if (old + 1u == (gen + 1u) * nloc) {
            __builtin_amdgcn_fence(__ATOMIC_RELEASE, "agent");
            asm volatile("s_waitcnt vmcnt(0)" ::: "memory");
            const unsigned og = xb_add(&bar[XB_TOP], 1u);
            const unsigned tg = og / nx;
            if (og + 1u == (tg + 1u) * nx) xb_add(&bar[XB_TOPGEN], 1u);
            else XB_SPIN(xb_ld(&bar[XB_TOPGEN]) == tg, bar);
            __builtin_amdgcn_fence(__ATOMIC_ACQUIRE, "agent");
            xb_add(&bar[XB_XGEN(b.x)], 1u);
            asm volatile("s_waitcnt vmcnt(0)" ::: "memory");
        } else {
            XB_SPIN(xb_ld(&bar[XB_XGEN(b.x)]) == gen, bar);
            __builtin_amdgcn_fence(__ATOMIC_ACQUIRE, "agent");
            asm volatile("s_waitcnt vmcnt(0)" ::: "memory");
        }
    }
    __syncthreads();
}

#ifndef PROBE_GEMM
#define PROBE_GEMM 1
#endif
#ifndef PROBE_MIX
#define PROBE_MIX 1
#endif
#ifndef PROBE_NORM
#define PROBE_NORM 1
#endif
#ifndef PROBE_SYNC
#define PROBE_SYNC 1
#endif
constexpr int NPHASE = 2 + 9 * NL + 1;
__global__ void __launch_bounds__(512, 2) fwd_megakernel(P parg) {
    extern __shared__ __attribute__((aligned(16))) unsigned char shm[];
    cg::grid_group grid = cg::this_grid();
    LAS unsigned char* lds = (LAS unsigned char*)shm;
    if (threadIdx.x < 4) ((volatile LAS unsigned*)(lds + 131072))[threadIdx.x] = 0u;
    if (blockIdx.x == 0) for (int i = threadIdx.x; i < XCD_BAR_WORDS; i += 512) parg.bar[i] = 0u;
    prep_phase(parg, shm);
    grid.sync();
    const XcdBarrier xb = xcd_barrier_post(parg.bar, (volatile LAS unsigned*)(lds + 131072));
    for (int ph = 1; ph < NPHASE; ++ph) {
        const P& p = parg;
        const int G = gridDim.x, bid = blockIdx.x;
        pg8::StaticOrder S;
        const int l = (ph - 2) / 9, kk = (ph - 2) % 9, k = (ph < 2) ? ph : (ph == NPHASE - 1 ? 10 : (kk < 3 ? 2 + kk : (kk == 3 ? 11 : 1 + kk)));
        const int nrep = (k == 3 || k == 6 || k == 8 || k == 9) ? PROBE_GEMM : (k == 4 || k == 5 || k == 11) ? PROBE_MIX : (k == 2 || k == 7) ? PROBE_NORM : 1;
        for (int rep = 0; rep < nrep; ++rep) {
        const float rs = (rep == nrep - 1) ? 1.f : 0.f;
        switch (k) {
        case 1: { pg8::Gemm g{p.cb, p.wt_ada, 256, MODLD, 1024}; S.init(256, MODLD, G, bid); EpiMod E{p.mod, p.b_ada}; pg8::gemm_phase(lds, g, S, E); } break;
        case 2: norm_phase(p, l, 0); break;
        case 3: { pg8::Gemm g{p.hb, p.wt_in + (size_t)l * DIN * 1024, MPAD, DIN, 1024}; S.init(MPAD, DIN, G, bid);
            EpiIn E{p.zb, p.cosT, p.sinT, p.out + O_POOLP + (size_t)l * NB * 15 * 512, p.out + O_POOLS + (size_t)l * SB * 15 * 512};
            pg8::gemm_phase(lds, g, S, E); } break;
        case 4:
            for (int it = bid; it < 1540; it += G) {
                if (it < 512) u_unit(p, it, shm);
                else if (it < 1024) sret_unit(p, l, it - 512, shm);
                else if (it < 1536) pool_unit(p, l, it - 1024, false, shm);
                else pool_unit(p, l, it - 1536, true, shm);
            }
            break;
        case 11: scan_phase(p, l); break;
        case 5: for (int it = bid; it < 512; it += G) o_unit(p, l, it, shm); break;
        case 6: { pg8::Gemm g{p.mixb, p.wt_out + (size_t)l * 1024 * 1024, MPAD, 1024, 1024}; S.init(MPAD, 1024, G, bid);
            EpiRes E{p.x, p.mod + l * MODW + 2 * DM, rs}; pg8::gemm_phase(lds, g, S, E); } break;
        case 7: norm_phase(p, l, 1); break;
        case 8: { pg8::Gemm g{p.hb, p.wt_gu + (size_t)l * 2 * DFF * 1024, MPAD, 2 * DFF, 1024}; S.init(MPAD, 2 * DFF, G, bid);
            EpiGu E{p.actb}; pg8::gemm_phase(lds, g, S, E); } break;
        case 9: { pg8::Gemm g{p.actb, p.wt_down + (size_t)l * 1024 * DFF, MPAD, 1024, DFF}; S.init(MPAD, 1024, G, bid);
            EpiRes E{p.x, p.mod + l * MODW + 5 * DM, rs}; pg8::gemm_phase(lds, g, S, E); } break;
        default: final_norm_phase(p); break;
        }
        if (rep != nrep - 1) xcd_barrier(xb);
        }
        for (int r2 = 1; r2 < PROBE_SYNC; ++r2) xcd_barrier(xb);
        if (ph != NPHASE - 1) xcd_barrier(xb);
    }
}

extern "C" void kernel_launch(void* const* d_in, const int* in_sizes, int n_in, void* d_out, int out_size, void* d_ws, size_t ws_size, hipStream_t stream) {
    static int grid_blocks = 0;
    size_t off = 0;
    auto take = [&](size_t bytes) { size_t o = off; off += (bytes + 255) & ~(size_t)255; return o; };
    const size_t o_wt_in = take((size_t)NL * DIN * 1024 * 2), o_wt_out = take((size_t)NL * 1024 * 1024 * 2), o_wt_gu = take((size_t)NL * 2 * DFF * 1024 * 2),
                 o_wt_down = take((size_t)NL * 1024 * DFF * 2), o_wt_ada = take((size_t)NL * MODW * 1024 * 2), o_wt_pool = take((size_t)NL * 4 * 16384 * 2),
                 o_cb = take((size_t)256 * 1024 * 2), o_hb = take((size_t)MPAD * 1024 * 2), o_zb = take((size_t)MPAD * DFF * 2), o_mixb = take((size_t)MPAD * 1024 * 2),
                 o_mod = take((size_t)NCOND * MODLD * 4), o_x = take((size_t)MPAD * 1024 * 4), o_U = take((size_t)512 * 16384 * 4),
                 o_cos = take((size_t)2049 * 64 * 4), o_sin = take((size_t)2049 * 64 * 4), o_Sb = take((size_t)512 * 16384 * 2), o_bar = take((size_t)XCD_BAR_WORDS * 4);
    if (grid_blocks == 0) {
        if (n_in != 18 || off > ws_size) { fprintf(stderr, "kernel_launch: need 18 inputs and %zu bytes of workspace, got %d / %zu\n", off, n_in, ws_size); grid_blocks = -1; return; }
        int dev = 0, cus = 0, per_cu = 0;
        (void)hipGetDevice(&dev);
        (void)hipDeviceGetAttribute(&cus, hipDeviceAttributeMultiprocessorCount, dev);
        if (hipFuncSetAttribute((const void*)fwd_megakernel, hipFuncAttributeMaxDynamicSharedMemorySize, LDS_BYTES) != hipSuccess) { fprintf(stderr, "kernel_launch: hipFuncSetAttribute failed\n"); grid_blocks = -1; return; }
        if (hipOccupancyMaxActiveBlocksPerMultiprocessor(&per_cu, (const void*)fwd_megakernel, 512, LDS_BYTES) != hipSuccess || per_cu < 1) { fprintf(stderr, "kernel_launch: occupancy query failed (%d)\n", per_cu); grid_blocks = -1; return; }
        grid_blocks = cus * per_cu;
    }
    if (grid_blocks < 0) return;
    P p{};
    const float** pin = (const float**)&p;
    for (int i = 0; i < 18; ++i) pin[i] = (const float*)d_in[i];
    p.out = (float*)d_out;
    unsigned char* ws = (unsigned char*)d_ws;
    p.wt_in = (bf16_t*)(ws + o_wt_in); p.wt_out = (bf16_t*)(ws + o_wt_out); p.wt_gu = (bf16_t*)(ws + o_wt_gu); p.wt_down = (bf16_t*)(ws + o_wt_down);
    p.wt_ada = (bf16_t*)(ws + o_wt_ada); p.wt_pool = (bf16_t*)(ws + o_wt_pool); p.cb = (bf16_t*)(ws + o_cb); p.hb = (bf16_t*)(ws + o_hb);
    p.zb = (bf16_t*)(ws + o_zb); p.actb = (bf16_t*)(ws + o_zb); p.mixb = (bf16_t*)(ws + o_mixb);
    p.mod = (float*)(ws + o_mod); p.x = (float*)(ws + o_x); p.U = (float*)(ws + o_U); p.cosT = (float*)(ws + o_cos); p.sinT = (float*)(ws + o_sin);
    p.Sb = (bf16_t*)(ws + o_Sb); p.bar = (unsigned*)(ws + o_bar);
    void* args[] = {&p};
    hipError_t e = hipLaunchCooperativeKernel((const void*)fwd_megakernel, dim3(grid_blocks), dim3(512), args, LDS_BYTES, stream);
    if (e != hipSuccess) fprintf(stderr, "cooperative launch failed: %s (grid %d)\n", hipGetErrorString(e), grid_blocks);
}
```
